# Optimizing an MI355X kernel written in HIP

```python
import math
import jax, jax.numpy as jnp
from jax import lax
import numpy as np

D_MODEL = 1024
BATCH = 8
SEQ = 4096
DEPTH = 4

N_MIXERS = 3
N_Q_HEADS = 16
N_KV_HEADS = 4
HEAD_DIM = D_MODEL // N_Q_HEADS
Q_BLOCK = 128
ROPE_THETA = 10000.0
GRID_W = 64
GMLP_CHUNK = 128
GMLP_WIDTH = 2 * D_MODEL
GMLP_GROUPS = 8
CONV_WIDTH = 3
N_EXPERTS = 32
TOP_K = 4
D_FF = D_MODEL
SWIGLU_ALPHA = 1.702
SWIGLU_LIMIT = 7.0
EXPERT_BLOCK = 128
LN_EPS = 1e-5
QK_EPS = 1e-6
DEEPNORM_ALPHA = (2 * DEPTH) ** 0.25
DEEPNORM_BETA = (8 * DEPTH) ** -0.25

kernel_name = "hybrid_interleaved_encoder_moe"


def _layers_of_kind(kind):
    return len(range(kind, DEPTH, N_MIXERS))


def layer_norm(x, g, b):
    xf = x.astype(jnp.float32)
    mu = jnp.mean(xf, -1, keepdims=True)
    var = jnp.mean(jnp.square(xf - mu), -1, keepdims=True)
    return ((xf - mu) * lax.rsqrt(var + LN_EPS) * g + b).astype(x.dtype)


def rms_norm(x, g):
    xf = x.astype(jnp.float32)
    return (xf * lax.rsqrt(jnp.mean(xf * xf, -1, keepdims=True) + QK_EPS) * g).astype(x.dtype)


def axial_rope_angles(seq_len):
    rows = seq_len // GRID_W
    grid = jnp.arange(rows * GRID_W, dtype=jnp.int32).reshape(rows, GRID_W)
    row = (grid // GRID_W).reshape(-1).astype(jnp.float32)
    col = (grid % GRID_W).reshape(-1).astype(jnp.float32)
    n_pairs = HEAD_DIM // 4
    inv = ROPE_THETA ** (-jnp.arange(n_pairs, dtype=jnp.float32) / n_pairs)
    ang = jnp.concatenate([row[:, None] * inv, col[:, None] * inv], -1)
    return jnp.cos(ang), jnp.sin(ang)


def apply_rope(x, cos, sin):
    xf = x.astype(jnp.float32).reshape(*x.shape[:-1], HEAD_DIM // 2, 2)
    x0, x1 = xf[..., 0], xf[..., 1]
    c, s = cos[:, None, :], sin[:, None, :]
    out = jnp.stack([x0 * c - x1 * s, x0 * s + x1 * c], -1)
    return out.reshape(x.shape).astype(x.dtype)


def attention_mixer(x, w_qkv, q_norm, k_norm, w_o):
    bsz, seq, _ = x.shape
    groups = N_Q_HEADS // N_KV_HEADS
    qkv = x @ w_qkv
    q, k, v = jnp.split(qkv, [N_Q_HEADS * HEAD_DIM, (N_Q_HEADS + N_KV_HEADS) * HEAD_DIM], axis=-1)
    q = rms_norm(q.reshape(bsz, seq, N_Q_HEADS, HEAD_DIM), q_norm)
    k = rms_norm(k.reshape(bsz, seq, N_KV_HEADS, HEAD_DIM), k_norm)
    v = v.reshape(bsz, seq, N_KV_HEADS, HEAD_DIM)
    cos, sin = axial_rope_angles(seq)
    q = apply_rope(q, cos, sin)
    k = apply_rope(k, cos, sin)
    n_blocks = seq // Q_BLOCK
    qb = q.reshape(bsz, n_blocks, Q_BLOCK, N_KV_HEADS, groups, HEAD_DIM).transpose(1, 0, 2, 3, 4, 5)
    scale = HEAD_DIM ** -0.5

    def query_block(q_blk):
        s = jnp.einsum('bqkgd,bskd->bkgqs', q_blk, k).astype(jnp.float32) * scale
        p = jax.nn.softmax(s, axis=-1).astype(v.dtype)
        return jnp.einsum('bkgqs,bskd->bqkgd', p, v)

    o = lax.map(query_block, qb)
    o = o.transpose(1, 0, 2, 3, 4, 5).reshape(bsz, seq, N_Q_HEADS * HEAD_DIM)
    return o @ w_o


def gmlp_mixer(x, w_in, norm_g, norm_b, w_s, b_s, w_out):
    bsz, seq, _ = x.shape
    z = jax.nn.gelu(x @ w_in, approximate=False)
    u, v = jnp.split(z, 2, axis=-1)
    v = layer_norm(v, norm_g, norm_b)
    n_chunks = seq // GMLP_CHUNK
    gw = GMLP_WIDTH // GMLP_GROUPS
    v = v.reshape(bsz, n_chunks, GMLP_CHUNK, GMLP_GROUPS, gw)
    mixed = jnp.einsum('gpq,bcqgd->bcpgd', w_s, v) + b_s.T[:, :, None]
    return (u * mixed.reshape(bsz, seq, GMLP_WIDTH)) @ w_out


def shortconv_mixer(x, w_in, conv_w, w_out):
    h = x @ w_in
    b_gate, c_gate, xv = jnp.split(h, 3, axis=-1)
    cx = c_gate * xv
    pad = jnp.pad(cx, ((0, 0), (1, 1), (0, 0)))
    y = pad[:, :-2] * conv_w[0] + pad[:, 1:-1] * conv_w[1] + pad[:, 2:] * conv_w[2]
    return (b_gate * y) @ w_out


def clamped_swiglu(h):
    h_glu = jnp.minimum(h[..., 0::2], SWIGLU_LIMIT)
    h_lin = jnp.clip(h[..., 1::2], -SWIGLU_LIMIT, SWIGLU_LIMIT)
    return h_glu * jax.nn.sigmoid(SWIGLU_ALPHA * h_glu) * (h_lin + 1.0)


def moe_ffn(x, router_w, router_b, w_gate_up, b_gate_up, w_down, b_down):
    bsz, seq, d = x.shape
    n_tok = bsz * seq
    xt = x.reshape(n_tok, d)
    logits = (xt @ router_w + router_b).astype(jnp.float32)
    top_logits, top_idx = lax.top_k(logits, TOP_K)
    gates = jax.nn.softmax(top_logits, axis=-1)
    n_assign = n_tok * TOP_K
    flat_e = top_idx.reshape(-1)
    order = jnp.argsort(flat_e)
    sorted_e = flat_e[order]
    sorted_tok = (order // TOP_K).astype(jnp.int32)
    sorted_gate = gates.reshape(-1)[order]
    counts = jnp.bincount(flat_e, length=N_EXPERTS)
    padded = (counts + EXPERT_BLOCK - 1) // EXPERT_BLOCK * EXPERT_BLOCK
    pad_end = jnp.cumsum(padded)
    pad_start = pad_end - padded
    start = jnp.cumsum(counts) - counts
    dest = pad_start[sorted_e] + jnp.arange(n_assign, dtype=jnp.int32) - start[sorted_e]
    n_blocks = -(-(n_assign + N_EXPERTS * (EXPERT_BLOCK - 1)) // EXPERT_BLOCK)
    n_rows = n_blocks * EXPERT_BLOCK
    row_tok = jnp.full((n_rows,), n_tok, jnp.int32).at[dest].set(sorted_tok)
    row_gate = jnp.zeros((n_rows,), jnp.float32).at[dest].set(sorted_gate)
    block_start = jnp.arange(n_blocks, dtype=jnp.int32) * EXPERT_BLOCK
    block_expert = jnp.minimum(jnp.searchsorted(pad_end, block_start, side='right'), N_EXPERTS - 1)
    x_pad = jnp.concatenate([xt, jnp.zeros((1, d), xt.dtype)], axis=0)
    xb = x_pad[row_tok].reshape(n_blocks, EXPERT_BLOCK, d)

    def expert_block(args):
        xblk, e = args
        h = xblk @ w_gate_up[e] + b_gate_up[e]
        return clamped_swiglu(h) @ w_down[e] + b_down[e]

    yb = lax.map(expert_block, (xb, block_expert))
    y = jnp.zeros((n_tok + 1, d), jnp.float32).at[row_tok].add(
        yb.reshape(n_rows, d).astype(jnp.float32) * row_gate[:, None])
    return y[:n_tok].astype(x.dtype).reshape(bsz, seq, d)


def setup_inputs(seed: int = 0) -> dict:
    key = jax.random.key(seed)
    ks = jax.random.split(key, 24)
    n_a, n_b, n_c = _layers_of_kind(0), _layers_of_kind(1), _layers_of_kind(2)
    d = D_MODEL
    qkv_w = (N_Q_HEADS + 2 * N_KV_HEADS) * HEAD_DIM

    def nrm(k, shape, scale):
        return jax.random.normal(k, shape, jnp.float32) * scale

    return {
        "x": nrm(ks[0], (BATCH, SEQ, d), 1.0),
        "attn_w_qkv": nrm(ks[1], (n_a, d, qkv_w), d ** -0.5),
        "attn_q_norm": 1.0 + nrm(ks[2], (n_a, HEAD_DIM), 0.02),
        "attn_k_norm": 1.0 + nrm(ks[3], (n_a, HEAD_DIM), 0.02),
        "attn_w_o": nrm(ks[4], (n_a, N_Q_HEADS * HEAD_DIM, d), (N_Q_HEADS * HEAD_DIM) ** -0.5 * DEEPNORM_BETA),
        "gmlp_w_in": nrm(ks[5], (n_b, d, 2 * GMLP_WIDTH), d ** -0.5),
        "gmlp_norm_g": 1.0 + nrm(ks[6], (n_b, GMLP_WIDTH), 0.02),
        "gmlp_norm_b": nrm(ks[7], (n_b, GMLP_WIDTH), 0.02),
        "gmlp_w_s": nrm(ks[8], (n_b, GMLP_GROUPS, GMLP_CHUNK, GMLP_CHUNK), GMLP_CHUNK ** -0.5),
        "gmlp_b_s": 1.0 + nrm(ks[9], (n_b, GMLP_GROUPS, GMLP_CHUNK), 0.02),
        "gmlp_w_out": nrm(ks[10], (n_b, GMLP_WIDTH, d), GMLP_WIDTH ** -0.5 * DEEPNORM_BETA),
        "conv_w_in": nrm(ks[11], (n_c, d, 3 * d), d ** -0.5),
        "conv_w": nrm(ks[12], (n_c, CONV_WIDTH, d), CONV_WIDTH ** -0.5),
        "conv_w_out": nrm(ks[13], (n_c, d, d), d ** -0.5 * DEEPNORM_BETA),
        "ln_mix_g": 1.0 + nrm(ks[14], (DEPTH, d), 0.02),
        "ln_mix_b": nrm(ks[15], (DEPTH, d), 0.02),
        "ln_ffn_g": 1.0 + nrm(ks[16], (DEPTH, d), 0.02),
        "ln_ffn_b": nrm(ks[17], (DEPTH, d), 0.02),
        "router_w": nrm(ks[18], (DEPTH, d, N_EXPERTS), d ** -0.5),
        "router_b": nrm(ks[19], (DEPTH, N_EXPERTS), 0.01),
        "expert_w_gate_up": nrm(ks[20], (DEPTH, N_EXPERTS, d, 2 * D_FF), d ** -0.5),
        "expert_b_gate_up": nrm(ks[21], (DEPTH, N_EXPERTS, 2 * D_FF), 0.02),
        "expert_w_down": nrm(ks[22], (DEPTH, N_EXPERTS, D_FF, d), D_FF ** -0.5 * DEEPNORM_BETA),
        "expert_b_down": nrm(ks[23], (DEPTH, N_EXPERTS, d), 0.02),
    }


def reference(x, attn_w_qkv, attn_q_norm, attn_k_norm, attn_w_o,
              gmlp_w_in, gmlp_norm_g, gmlp_norm_b, gmlp_w_s, gmlp_b_s, gmlp_w_out,
              conv_w_in, conv_w, conv_w_out,
              ln_mix_g, ln_mix_b, ln_ffn_g, ln_ffn_b,
              router_w, router_b, expert_w_gate_up, expert_b_gate_up,
              expert_w_down, expert_b_down):
    for i in range(DEPTH):
        kind = i % N_MIXERS
        j = i // N_MIXERS
        if kind == 0:
            h = attention_mixer(x, attn_w_qkv[j], attn_q_norm[j], attn_k_norm[j], attn_w_o[j])
        elif kind == 1:
            h = gmlp_mixer(x, gmlp_w_in[j], gmlp_norm_g[j], gmlp_norm_b[j],
                           gmlp_w_s[j], gmlp_b_s[j], gmlp_w_out[j])
        else:
            h = shortconv_mixer(x, conv_w_in[j], conv_w[j], conv_w_out[j])
        x = layer_norm(DEEPNORM_ALPHA * x + h, ln_mix_g[i], ln_mix_b[i])
        f = moe_ffn(x, router_w[i], router_b[i], expert_w_gate_up[i], expert_b_gate_up[i],
                    expert_w_down[i], expert_b_down[i])
        x = layer_norm(DEEPNORM_ALPHA * x + f, ln_ffn_g[i], ln_ffn_b[i])
    return x
```

```cpp
#include <hip/hip_runtime.h>
#include <hip/hip_bf16.h>
#include <cstdio>
#include <cstdint>
#include <cmath>
namespace pg8 {
#define PG8_LAS __attribute__((address_space(3)))
typedef unsigned short bf16_t;
typedef short bf16x8 __attribute__((ext_vector_type(8)));
typedef float f32x4 __attribute__((ext_vector_type(4)));
typedef float f32x2 __attribute__((ext_vector_type(2)));
typedef unsigned u32x4 __attribute__((ext_vector_type(4)));
typedef unsigned u32x2 __attribute__((ext_vector_type(2)));
typedef int v4i32_t __attribute__((ext_vector_type(4)));
typedef int v8i32_t __attribute__((ext_vector_type(8)));
constexpr int BM = 256, BK = 64, HALF = 128, HTB = HALF * BK * 2  , STAGE_BYTES = 8 * HTB, NXCD = 8, WGM = 8;

__host__ __device__ __forceinline__ int lds_byte(int r, int c) { const int st = (r >> 4) * 2 + (c >> 5), rr = r & 15, cc = c & 31, ob = rr * 64 + cc * 2; return st * 1024 + (ob ^ (((ob >> 9) & 1) << 5)); }
__host__ __device__ __forceinline__ void stage_rc(int b, int& R, int& C) { const int st = b / 1024, sb = b % 1024, swz = sb ^ (((sb >> 9) & 1) << 5); R = (st >> 1) * 16 + swz / 64; C = (st & 1) * 32 + (swz % 64) / 2; }
__host__ __device__ __forceinline__ int perm32(int rho) { const int n = rho >> 4, i = rho & 15; return 8 * (i >> 2) + 4 * n + (i & 3); }

struct Unit { int pm, pn, e, lt, cnt, ms; };

template <int WGM_ = WGM> __device__ __forceinline__ bool order_map(int i, int G, int c, int nM, int nN, int& pm, int& pn) {
    const int nwg = nM * nN; const long L = (long)i * G + c; if (L >= nwg) return false;
    int wgid = (int)L; { const int q = nwg / NXCD, r = nwg % NXCD, xcd = wgid % NXCD, off = wgid / NXCD; wgid = (xcd < r ? xcd * (q + 1) : r * (q + 1) + (xcd - r) * q) + off; }
    const int nig = WGM_ * nN, gid = wgid / nig, fm = gid * WGM_, gsz = (nM - fm) < WGM_ ? (nM - fm) : WGM_;
    pm = fm + ((wgid % nig) % gsz); pn = (wgid % nig) / gsz; return true;
}
#ifndef FUSE_GD
#define FUSE_GD 1
#endif
#ifndef FUSE_PL
#define FUSE_PL 1
#endif
constexpr int UTAB_OFF = 131072 + 3 * 2048, UTAB_N = 32;
constexpr int META_OFF = 131072, META_SLOT = 2048;
struct DenseSched {
    static constexpr bool GATHER = false, META = false;
    __device__ __forceinline__ void meta_dma(const Unit&, PG8_LAS unsigned char*, int, int) const {}
    const void* A; const void* Bt; int ldaB, KB, nM, nN, G, c;
    int fused, r0, ntl, rk, nxc; unsigned* rdy;
    __device__ __forceinline__ bool next(int i, Unit& u) const { u.e = 0; u.lt = 0; u.cnt = 0; u.ms = 0;
        if (!fused) return order_map(i, G, c, nM, nN, u.pm, u.pn);
        const int kk = i * nxc + rk; if (kk >= ntl * nN) return false;
        const int nig = 8 * nN, gid = kk / nig, fm = gid * 8, gsz = (ntl - fm) < 8 ? (ntl - fm) : 8;
        u.pm = r0 + fm + ((kk % nig) % gsz); u.pn = (kk % nig) / gsz; return true; }
    __device__ __forceinline__ bool next_lane(int i, Unit& u) const { return next(i, u); }
    __device__ __forceinline__ void signal(int pm, int tid) const { if (fused && tid == 0) (void)__hip_atomic_fetch_add(rdy + pm, 1u, __ATOMIC_RELAXED, __HIP_MEMORY_SCOPE_AGENT); }
    __device__ __forceinline__ void wait_ready(int) const {}
    static constexpr int A_AUX = 0;
    __device__ __forceinline__ const char* a_base(const Unit& u) const { return (const char*)A + (size_t)u.pm * BM * ldaB; }
    __device__ __forceinline__ const char* b_base(const Unit& u) const { return (const char*)Bt + (size_t)u.pn * BM * KB; }
    __device__ __forceinline__ size_t a_hstep() const { return (size_t)HALF * ldaB; }
    __device__ __forceinline__ void a_offs(const Unit&, int tid, unsigned (&off)[2][2], PG8_LAS unsigned char*) const {
#pragma unroll
        for (int h = 0; h < 2; ++h)
#pragma unroll
            for (int i = 0; i < 2; ++i) { int R, C; stage_rc(tid * 16 + i * 8192, R, C); off[h][i] = (unsigned)((h * HALF + R) * ldaB + C * 2); }
    }
};
template <bool GATHER_> struct GroupedSched {
    static constexpr bool GATHER = GATHER_, META = true;
    static constexpr int A_AUX = (FUSE_GD && !GATHER_) ? 1 : 0;
    const void* A; const void* W; const int* list; const float* glist; const PG8_LAS int* tstart; const PG8_LAS int* cnt; int KB, N, nN, TM, G, c;
    int fused, r0, ntl, rk, nxc, kbase; unsigned* rdy;
    __device__ __forceinline__ bool map_unit(int i, int& pm, int& pn) const {
        if (!fused) return order_map<4>(i, G, c, TM, nN, pm, pn);
        const int kk = i * nxc + rk + kbase; if (kk < 0 || kk >= ntl * nN) return false;
        const int nig = 4 * nN, gid = kk / nig, fm = gid * 4, gsz = (ntl - fm) < 4 ? (ntl - fm) : 4;
        pm = r0 + fm + ((kk % nig) % gsz); pn = (kk % nig) / gsz; return true;
    }
    __device__ __forceinline__ void signal(int pm, int tid) const { if (fused && GATHER && tid == 0) (void)__hip_atomic_fetch_add(rdy + pm, 1u, __ATOMIC_RELAXED, __HIP_MEMORY_SCOPE_AGENT); }
    __device__ __forceinline__ void wait_ready(int pm) const {
        if (fused && !GATHER) { unsigned sp = 0; while (__hip_atomic_load(rdy + pm, __ATOMIC_RELAXED, __HIP_MEMORY_SCOPE_AGENT) < 8u) { __builtin_amdgcn_s_sleep(2); if (++sp > (1u << 20)) break; } } }
    __device__ __forceinline__ bool next(int i, Unit& u) const {
        if (!map_unit(i, u.pm, u.pn)) return false;
        int lo = 0, hi = 32;
#pragma unroll
        for (int s = 0; s < 5; ++s) { const int mid = (lo + hi) >> 1; const int v = __builtin_amdgcn_readfirstlane(tstart[mid]); if (v <= u.pm) lo = mid; else hi = mid; }
        u.e = lo; u.lt = u.pm - __builtin_amdgcn_readfirstlane(tstart[lo]); u.cnt = __builtin_amdgcn_readfirstlane(cnt[lo]); u.ms = (i % 3) * META_SLOT; return true;
    }
    __device__ __forceinline__ bool next_lane(int i, Unit& u) const {
        if (!map_unit(i, u.pm, u.pn)) return false;
        int lo = 0, hi = 32;
#pragma unroll
        for (int s = 0; s < 5; ++s) { const int mid = (lo + hi) >> 1; const int v = tstart[mid]; if (v <= u.pm) lo = mid; else hi = mid; }
        u.e = lo; u.lt = u.pm - tstart[lo]; u.cnt = cnt[lo]; u.ms = (i % 3) * META_SLOT; return true;
    }
    __device__ __forceinline__ void meta_dma(const Unit& u, PG8_LAS unsigned char* lds, int wid, int lane) const {
        const size_t src = (size_t)u.e * 32768 + (size_t)u.lt * BM + (wid & 3) * 64 + lane;
        const void* g = (wid < 4) ? (const void*)(list + src) : (const void*)(glist + src);
        __builtin_amdgcn_global_load_lds((const unsigned*)g, (PG8_LAS unsigned*)(lds + META_OFF + u.ms + (wid >> 2) * 1024 + (wid & 3) * 256), 4, 0, 0);
    }
    __device__ __forceinline__ const char* a_base(const Unit& u) const { return GATHER ? (const char*)A : (const char*)A + (size_t)u.pm * BM * KB; }
    __device__ __forceinline__ const char* b_base(const Unit& u) const { return (const char*)W + ((size_t)u.e * N + (size_t)u.pn * BM) * KB; }
    __device__ __forceinline__ size_t a_hstep() const { return (size_t)HALF * KB; }
    __device__ __forceinline__ void a_offs(const Unit& u, int tid, unsigned (&off)[2][2], PG8_LAS unsigned char* lds) const {
#pragma unroll
        for (int h = 0; h < 2; ++h)
#pragma unroll
            for (int i = 0; i < 2; ++i) { int R, C; stage_rc(tid * 16 + i * 8192, R, C);
                if (GATHER) { const int r = h * HALF + R; const int a = ((const PG8_LAS int*)(lds + META_OFF + u.ms))[r]; const int tok = (u.lt * BM + r < u.cnt) ? (a >> 2) : 0; off[h][i] = (unsigned)(tok * KB + C * 2); }
                else off[h][i] = (unsigned)((h * HALF + R) * KB + C * 2);
            }
    }
};

__device__ __forceinline__ unsigned cvt_pk_bf16(float lo, float hi) { unsigned r; asm volatile("v_cvt_pk_bf16_f32 %0, %1, %2" : "=v"(r) : "v"(lo), "v"(hi)); return r; }
__device__ __forceinline__ f32x2 gelu_pk(f32x2 v) {
    const f32x2 av = __builtin_elementwise_abs(v), d = av * 0.2316418882f + 1.0f;
    f32x2 t; t.x = __builtin_amdgcn_rcpf(d.x); t.y = __builtin_amdgcn_rcpf(d.y);
    f32x2 q = t * 0.5307027145f + (-0.7265760135f); q = q * t + 0.7107068705f; q = q * t + (-0.142248368f); q = q * t + 0.127414796f; q = q * t;
    const f32x2 s = (v * v) * (-0.72134752044f);
    f32x2 e; e.x = __builtin_amdgcn_exp2f(s.x); e.y = __builtin_amdgcn_exp2f(s.y);
    const f32x2 m = v * (q * e), r = v - m;
    f32x2 o; o.x = v.x < 0.f ? m.x : r.x; o.y = v.y < 0.f ? m.y : r.y; return o;
}
template <int ACT, int QKV> struct EpiBf16 {
    static constexpr bool PERM = true; static constexpr int NSTORE = 16, NPRE = 0, EID = 4;
    bf16_t* O; int ldc; bf16_t* O2; bf16_t* O3;
    struct Pre {};
    __device__ __forceinline__ void prefetch(Pre&, const Unit&, int, int, int) const {}
    __device__ __forceinline__ void init(f32x4 (&acc)[2][2][4][2], const Pre&) const {
#pragma unroll
        for (int a = 0; a < 2; ++a)
#pragma unroll
            for (int b = 0; b < 2; ++b)
#pragma unroll
                for (int m = 0; m < 4; ++m)
#pragma unroll
                    for (int n = 0; n < 2; ++n) acc[a][b][m][n] = (f32x4){0.f, 0.f, 0.f, 0.f};
    }
    __device__ __forceinline__ void operator()(const f32x4 (&acc)[2][2][4][2], const Unit& u, int wr, int wc, int fr, int fq, const Pre&) const {
        const int row0 = u.pm * BM + wr * 64 + fr; int colt = u.pn * BM; bf16_t* base = O; int ld = ldc;
        if (QKV) { if (u.pn == 4) { base = O2; ld = 256; colt = 0; } else if (u.pn == 5) { base = O3; ld = 256; colt = 0; } }
        const int col0 = colt + wc * 32 + 8 * fq;
#pragma unroll
        for (int ai = 0; ai < 2; ++ai)
#pragma unroll
            for (int m = 0; m < 4; ++m) { bf16_t* rowp = base + (size_t)(row0 + ai * HALF + m * 16) * ld + col0;
#pragma unroll
                for (int bj = 0; bj < 2; ++bj) { f32x4 v0 = acc[ai][bj][m][0], v1 = acc[ai][bj][m][1];
                    if (ACT == 1) { f32x2 a = gelu_pk((f32x2){v0[0], v0[1]}), b = gelu_pk((f32x2){v0[2], v0[3]}), c = gelu_pk((f32x2){v1[0], v1[1]}), d = gelu_pk((f32x2){v1[2], v1[3]});
                        v0 = (f32x4){a.x, a.y, b.x, b.y}; v1 = (f32x4){c.x, c.y, d.x, d.y}; }
                    u32x4 w; w.x = cvt_pk_bf16(v0[0], v0[1]); w.y = cvt_pk_bf16(v0[2], v0[3]); w.z = cvt_pk_bf16(v1[0], v1[1]); w.w = cvt_pk_bf16(v1[2], v1[3]);
                    *(u32x4*)(rowp + bj * HALF) = w; } }
    }
};
__device__ __forceinline__ float swiglu1(float g, float l) {
    g = fminf(g, 7.0f); l = fminf(fmaxf(l, -7.0f), 7.0f);
    const float s = __builtin_amdgcn_rcpf(1.0f + __builtin_amdgcn_exp2f(g * (-1.702f * 1.4426950408889634f)));
    return g * s * (l + 1.0f);
}
__device__ __forceinline__ float swiglu1b(float g, float l1) {
    g = fminf(g, 7.0f); l1 = __builtin_amdgcn_fmed3f(l1, -6.0f, 8.0f);
    const float s = __builtin_amdgcn_rcpf(1.0f + __builtin_amdgcn_exp2f(g * (-1.702f * 1.4426950408889634f)));
    return g * s * l1;
}
struct EpiSwiglu {
    static constexpr bool PERM = true; static constexpr int NSTORE = 8, NPRE = 0, EID = 0;
    bf16_t* Hm; const float* biasp;
    struct Pre {};
    __device__ __forceinline__ void prefetch(Pre&, const Unit&, int, int, int) const {}
    __device__ __forceinline__ void init(f32x4 (&acc)[2][2][4][2], const Pre&) const {
#pragma unroll
        for (int a = 0; a < 2; ++a)
#pragma unroll
            for (int b = 0; b < 2; ++b)
#pragma unroll
                for (int m = 0; m < 4; ++m)
#pragma unroll
                    for (int n = 0; n < 2; ++n) acc[a][b][m][n] = (f32x4){0.f, 0.f, 0.f, 0.f};
    }
    __device__ __forceinline__ void operator()(const f32x4 (&acc)[2][2][4][2], const Unit& u, int wr, int wc, int fr, int fq, const Pre&) const {
        const int row0 = u.pm * BM + wr * 64 + fr, col0 = u.pn * HALF + wc * 32 + 8 * fq;
        const float* bp = biasp + (size_t)u.e * 2048 + u.pn * BM + wc * 32 + 8 * fq;
        f32x4 bg[2], bl[2];
#pragma unroll
        for (int n = 0; n < 2; ++n) { bg[n] = *(const f32x4*)(bp + 4 * n); bl[n] = *(const f32x4*)(bp + HALF + 4 * n); }
#pragma unroll
        for (int ai = 0; ai < 2; ++ai)
#pragma unroll
            for (int m = 0; m < 4; ++m) { bf16_t* rowp = Hm + (size_t)(row0 + ai * HALF + m * 16) * 1024 + col0;
                float o[8];
#pragma unroll
                for (int n = 0; n < 2; ++n) { const f32x4 g = acc[ai][0][m][n] + bg[n], l = acc[ai][1][m][n] + bl[n];
#pragma unroll
                    for (int j = 0; j < 4; ++j) o[4 * n + j] = swiglu1(g[j], l[j]); }
                u32x4 w; w.x = cvt_pk_bf16(o[0], o[1]); w.y = cvt_pk_bf16(o[2], o[3]); w.z = cvt_pk_bf16(o[4], o[5]); w.w = cvt_pk_bf16(o[6], o[7]);
                *(u32x4*)rowp = w; }
    }
};
__device__ __forceinline__ unsigned pk4_fp8(float a, float b, float c, float d) { int w = 0; w = __builtin_amdgcn_cvt_pk_fp8_f32(a, b, w, false); w = __builtin_amdgcn_cvt_pk_fp8_f32(c, d, w, true); return (unsigned)w; }
struct EpiSwiglu8 {
    static constexpr bool PERM = true; static constexpr int NSTORE = 4, EID = 1;
    unsigned char* Hm; const float* biasp;
    static constexpr int NPRE = 4;
    struct Pre { f32x4 bg[2], bl[2]; };
    __device__ __forceinline__ void prefetch(Pre& p, const Unit& u, int wc, int fr, int fq) const {
        const float* bp = biasp + (size_t)u.e * 2048 + u.pn * BM + wc * 32 + 8 * fq;
#pragma unroll
        for (int n = 0; n < 2; ++n) { p.bg[n] = *(const f32x4*)(bp + 4 * n); p.bl[n] = *(const f32x4*)(bp + HALF + 4 * n); }
    }
    __device__ __forceinline__ void init(f32x4 (&acc)[2][2][4][2], const Pre& p) const {
#pragma unroll
        for (int a = 0; a < 2; ++a)
#pragma unroll
            for (int m = 0; m < 4; ++m)
#pragma unroll
                for (int n = 0; n < 2; ++n) { acc[a][0][m][n] = p.bg[n]; acc[a][1][m][n] = p.bl[n] + 1.0f; }
    }
    __device__ __forceinline__ void operator()(const f32x4 (&acc)[2][2][4][2], const Unit& u, int wr, int wc, int fr, int fq, const Pre&) const {
        const int row0 = u.pm * BM + wr * 64 + fr, col0 = u.pn * HALF + wc * 32 + 8 * fq;
        unsigned char* base = Hm + (size_t)(row0 + (fq & 1) * 16) * 1024 + (col0 - 8 * (fq & 1));
#pragma unroll
        for (int ai = 0; ai < 2; ++ai)
#pragma unroll
            for (int mp = 0; mp < 2; ++mp) {
                u32x2 w[2];
#pragma unroll
                for (int mm = 0; mm < 2; ++mm) { const int m = 2 * mp + mm;
                    float o[8];
#pragma unroll
                    for (int n = 0; n < 2; ++n) { const f32x4 g = acc[ai][0][m][n], l = acc[ai][1][m][n];
#pragma unroll
                        for (int j = 0; j < 4; ++j) o[4 * n + j] = swiglu1b(g[j], l[j]); }
                    w[mm].x = pk4_fp8(o[0], o[1], o[2], o[3]); w[mm].y = pk4_fp8(o[4], o[5], o[6], o[7]); }
                const auto sx = __builtin_amdgcn_permlane16_swap(w[0].x, w[1].x, false, false), sy = __builtin_amdgcn_permlane16_swap(w[0].y, w[1].y, false, false);
                u32x4 q; q.x = sx[0]; q.y = sy[0]; q.z = sx[1]; q.w = sy[1];
                *(u32x4*)(base + (size_t)(ai * HALF + mp * 32) * 1024) = q; }
    }
};
struct EpiDown {
    static constexpr int PERM = 2; static constexpr int NSTORE = 8, EID = 2;
    unsigned char* Y; const float* bias; PG8_LAS unsigned char* lds;
    static constexpr int NPRE = 4;
    struct Pre { f32x4 bv[2][2]; };
    __device__ __forceinline__ void prefetch(Pre& p, const Unit& u, int wc, int fr, int fq) const {
        const float* bp = bias + (size_t)u.e * 1024 + u.pn * BM + wc * 64 + 16 * fq;
#pragma unroll
        for (int bj = 0; bj < 2; ++bj) { p.bv[bj][0] = *(const f32x4*)(bp + bj * 8); p.bv[bj][1] = *(const f32x4*)(bp + bj * 8 + 4); }
    }
    __device__ __forceinline__ void init(f32x4 (&acc)[2][2][4][2], const Pre& p) const {
#pragma unroll
        for (int a = 0; a < 2; ++a)
#pragma unroll
            for (int b = 0; b < 2; ++b)
#pragma unroll
                for (int m = 0; m < 4; ++m)
#pragma unroll
                    for (int n = 0; n < 2; ++n) acc[a][b][m][n] = p.bv[b][n];
    }
    __device__ __forceinline__ void operator()(const f32x4 (&acc)[2][2][4][2], const Unit& u, int wr, int wc, int fr, int fq, const Pre&) const {
        const int lr0 = wr * 64 + fr, col0 = u.pn * BM + wc * 64 + 16 * fq;
        const PG8_LAS int* ids = (const PG8_LAS int*)(lds + META_OFF + u.ms); const PG8_LAS float* gts = (const PG8_LAS float*)(lds + META_OFF + u.ms + 1024);
#pragma unroll
        for (int ai = 0; ai < 2; ++ai)
#pragma unroll
            for (int m = 0; m < 4; ++m) { const int lr = lr0 + ai * HALF + m * 16;
                int a = ids[lr]; a = (u.lt * BM + lr < u.cnt) ? a : 131072;
                const float g = gts[lr] * 64.0f; unsigned char* rowp = Y + (size_t)a * 1024 + col0;
                u32x4 w;
#pragma unroll
                for (int bj = 0; bj < 2; ++bj) {
                    const f32x4 v0 = acc[ai][bj][m][0] * g, v1 = acc[ai][bj][m][1] * g;
                    w[2 * bj] = pk4_fp8(v0[0], v0[1], v0[2], v0[3]); w[2 * bj + 1] = pk4_fp8(v1[0], v1[1], v1[2], v1[3]); }
                *(u32x4*)rowp = w;
                asm volatile("" ::: "memory"); }
    }
};

template <bool FP8, class Epi, class Sched>
__device__ __forceinline__ void gemm_phase(PG8_LAS unsigned char* lds, const int KB  , const Sched& S, const Epi& E, const int tid, const int wscale = 0x7F7F7F7F, const int ascale = 0x7F7F7F7F) {
    const int wid = __builtin_amdgcn_readfirstlane(tid >> 6), lane = tid & 63, wr = wid >> 2, wc = wid & 3, fr = lane & 15, fq = lane >> 4;
    const int nt = KB / 128;
    unsigned voffB[2];
#pragma unroll
    for (int i = 0; i < 2; ++i) { int R, C; stage_rc(tid * 16 + i * 8192, R, C); const int Rb = (int)Epi::PERM == 2 ? (64 * (R >> 5) + 16 * ((R & 15) >> 2) + 4 * ((R >> 4) & 1) + (R & 3)) : Epi::PERM ? ((R & ~31) + perm32(R & 31)) : R; voffB[i] = (unsigned)(Rb * KB + C * 2); }
    const size_t kstep = (size_t)(BK * 2);
    const size_t hstep = (size_t)((int)Epi::PERM == 2 ? 8 : HALF) * KB;
    const size_t hstepA = S.a_hstep();
    const unsigned ldsw = (unsigned)wid * 1024u;
    const int aoff = lds_byte(wr * 64 + fr, fq * 8), boff = lds_byte(wc * 32 + fr, fq * 8);
#define PG8_SA(b, h) (((b) * 2 + (h)) * HTB)
#define PG8_SB(b, h) ((4 + (b) * 2 + (h)) * HTB)
#define PG8_STAGE(bufoff, gbase, voff) do { _Pragma("unroll") for (int _i = 0; _i < 2; ++_i) \
        __builtin_amdgcn_global_load_lds((const unsigned*)((const char*)(gbase) + (voff)[_i]), (PG8_LAS unsigned*)(lds + (bufoff) + ldsw + _i * 8192), 16, 0, 0); } while (0)
#define PG8_STAGE_X(bufoff, gbase, voff) do { _Pragma("unroll") for (int _i = 0; _i < 2; ++_i) \
        __builtin_amdgcn_global_load_lds((const unsigned*)((const char*)(gbase) + (voff)[_i]), (PG8_LAS unsigned*)(lds + (bufoff) + ldsw + _i * 8192), 16, 0, Sched::A_AUX); } while (0)
#define PG8_STAGE_A(bufoff, gbase, offs, half) do { if (Sched::GATHER) PG8_STAGE(bufoff, gbase, (offs)[half]); else PG8_STAGE_X(bufoff, (gbase) + (half) * hstepA, (offs)[0]); } while (0)
#define PG8_LD8(p) __builtin_shufflevector(*(const PG8_LAS v4i32_t*)(p), *(const PG8_LAS v4i32_t*)((p) + 1024), 0, 1, 2, 3, 4, 5, 6, 7)
#define PG8_LDA(dst, b, h) do { _Pragma("unroll") for (int m = 0; m < 4; ++m) dst[m] = PG8_LD8(lds + PG8_SA(b, h) + aoff + m * 2048); } while (0)
#define PG8_LDB(dst, b, h) do { _Pragma("unroll") for (int n = 0; n < 2; ++n) dst[n] = PG8_LD8(lds + PG8_SB(b, h) + boff + n * 2048); } while (0)
#define PG8_HALF(x, k) __builtin_bit_cast(bf16x8, (k) ? __builtin_shufflevector((x), (x), 4, 5, 6, 7) : __builtin_shufflevector((x), (x), 0, 1, 2, 3))
#define PG8_MMA(ai, bj, At, Bt) do { __builtin_amdgcn_s_setprio(1); _Pragma("unroll") for (int m = 0; m < 4; ++m) _Pragma("unroll") for (int n = 0; n < 2; ++n) { \
        if constexpr (FP8) asm volatile("v_mfma_scale_f32_16x16x128_f8f6f4 %0, %1, %2, %0, %3, %4 op_sel_hi:[0,0,0]" : "+v"(acc[ai][bj][m][n]) : "v"(Bt[n]), "v"(At[m]), "v"(wsc_v), "v"(one_v));     \
        else { _Pragma("unroll") for (int k = 0; k < 2; ++k) acc[ai][bj][m][n] = __builtin_amdgcn_mfma_f32_16x16x32_bf16(PG8_HALF(Bt[n], k), PG8_HALF(At[m], k), acc[ai][bj][m][n], 0, 0, 0); } } \
        __builtin_amdgcn_s_setprio(0); } while (0)
#define PG8_WAIT_V(n) asm volatile("s_waitcnt vmcnt(" #n ")" ::: "memory")
#define PG8_WAIT_VX(n, fresh) do { if (fresh) asm volatile("s_waitcnt vmcnt(%0)" :: "n"((n) + Epi::NSTORE + (Sched::META ? 1 : 0)) : "memory"); else PG8_WAIT_V(n); } while (0)
#define PG8_WAIT_L(n) asm volatile("s_waitcnt lgkmcnt(" #n ")" ::: "memory")
#define PG8_BAR __builtin_amdgcn_s_barrier()
#define PG8_SCHED __builtin_amdgcn_sched_barrier(0)
    PG8_LAS int* utab = (PG8_LAS int*)(lds + UTAB_OFF);
    if (tid < UTAB_N) { Unit tu; const bool ok = S.next_lane(tid, tu); v4i32_t t4; t4.x = ok ? tu.pm : -1; t4.y = tu.pn; t4.z = tu.e; t4.w = tu.lt; *(PG8_LAS v4i32_t*)(utab + tid * 8) = t4; utab[tid * 8 + 4] = tu.cnt; }
    __syncthreads();
#define PG8_NEXT(i, u) ([&]() -> bool { if ((i) >= UTAB_N) return S.next((i), (u)); const v4i32_t t4 = *(const PG8_LAS v4i32_t*)(utab + (i) * 8); const int pm_ = __builtin_amdgcn_readfirstlane(t4.x); if (pm_ < 0) return false; \
        (u).pm = pm_; (u).pn = __builtin_amdgcn_readfirstlane(t4.y); (u).e = __builtin_amdgcn_readfirstlane(t4.z); (u).lt = __builtin_amdgcn_readfirstlane(t4.w); (u).cnt = __builtin_amdgcn_readfirstlane(utab[(i) * 8 + 4]); (u).ms = Sched::META ? ((i) % 3) * META_SLOT : 0; return true; }())
    Unit cur, nxt; int ui = 0, prev_pm = 0;
    if (!PG8_NEXT(0, cur)) return;
    S.wait_ready(cur.pm);
    f32x4 acc[2][2][4][2];
    typename Epi::Pre pre; E.prefetch(pre, cur, wc, fr, fq); E.init(acc, pre);
    v8i32_t At[4], B0[2], B1[2];
    int wsc_v = wscale, one_v = ascale; asm volatile("" : "+v"(wsc_v), "+v"(one_v));
    unsigned offC[2][2];
    if constexpr (Sched::META) { S.meta_dma(cur, lds, wid, lane); PG8_WAIT_V(0); PG8_BAR; }
    S.a_offs(cur, tid, offC, lds);
    const char* cA = S.a_base(cur); const char* cB = S.b_base(cur);
    PG8_STAGE(PG8_SB(0, 0), cB, voffB); PG8_STAGE(PG8_SB(0, 1), cB + hstep, voffB); PG8_STAGE_A(PG8_SA(0, 0), cA, offC, 0); PG8_STAGE_A(PG8_SA(0, 1), cA, offC, 1);
    if (wr == 1) PG8_BAR;
    PG8_WAIT_V(2); PG8_BAR;
    PG8_STAGE(PG8_SB(1, 0), cB + kstep, voffB); PG8_STAGE_A(PG8_SA(1, 0), cA + kstep, offC, 0); PG8_STAGE(PG8_SB(1, 1), cB + hstep + kstep, voffB);
    PG8_WAIT_V(6); PG8_BAR;
    for (;;) {
        const bool has_next = PG8_NEXT(ui + 1, nxt);
        if (has_next) S.wait_ready(nxt.pm);
        const char* nA = has_next ? S.a_base(nxt) : cA; const char* nB = has_next ? S.b_base(nxt) : cB;
        if constexpr (Sched::META) { if (has_next) S.meta_dma(nxt, lds, wid, lane); }
#pragma unroll 1
        for (int t = 0; t < nt; t += 2) {
            const bool last = (t == nt - 2); const bool fresh = (t == 0) && (ui > 0);
            const char* a1 = cA + (size_t)(t + 1) * kstep;
            const char* a2 = last ? nA : cA + (size_t)(t + 2) * kstep; const char* b2 = last ? nB : cB + (size_t)(t + 2) * kstep;
            const char* a3 = a2 + kstep; const char* b3 = b2 + kstep;
            PG8_LDB(B0, 0, 0); PG8_LDB(B1, 0, 1); PG8_SCHED; PG8_LDA(At, 0, 0); if (!fresh) PG8_STAGE_A(PG8_SA(1, 1), a1, offC, 1);
            if (Sched::GATHER && last && has_next) S.a_offs(nxt, tid, offC, lds);
            PG8_WAIT_VX(8, fresh); PG8_WAIT_L(0); PG8_BAR; PG8_MMA(0, 0, At, B0); PG8_MMA(0, 1, At, B1); PG8_BAR; PG8_SCHED;
            PG8_LDA(At, 0, 1); PG8_STAGE(PG8_SB(0, 0), b2, voffB); PG8_STAGE(PG8_SB(0, 1), b2 + hstep, voffB); PG8_STAGE_A(PG8_SA(0, 0), a2, offC, 0);
            if (fresh) { PG8_WAIT_VX(14, true); } else { PG8_WAIT_V(8); }
            PG8_WAIT_L(0); PG8_BAR; PG8_MMA(1, 0, At, B0); PG8_MMA(1, 1, At, B1); PG8_BAR; PG8_SCHED;
            PG8_LDB(B0, 1, 0); PG8_LDB(B1, 1, 1); PG8_SCHED; PG8_LDA(At, 1, 0); PG8_STAGE_A(PG8_SA(0, 1), a2, offC, 1);
            if (fresh) { PG8_WAIT_VX(10, true); } else { PG8_WAIT_V(8); }
            PG8_WAIT_L(0); PG8_BAR; PG8_MMA(0, 0, At, B0); PG8_MMA(0, 1, At, B1); PG8_BAR; PG8_SCHED;
            PG8_LDA(At, 1, 1); PG8_STAGE(PG8_SB(1, 0), b3, voffB); PG8_STAGE(PG8_SB(1, 1), b3 + hstep, voffB); PG8_STAGE_A(PG8_SA(1, 0), a3, offC, 0);
            if (fresh) { PG8_WAIT_VX(14, true); } else { PG8_WAIT_V(8); }
            PG8_WAIT_L(0); PG8_BAR; PG8_MMA(1, 0, At, B0); PG8_MMA(1, 1, At, B1); PG8_BAR; PG8_SCHED;
        }
        if (has_next) E.prefetch(pre, nxt, wc, fr, fq);
        if (has_next) PG8_STAGE_A(PG8_SA(1, 1), nA + kstep, offC, 1);
        if (wr == 0) PG8_BAR;
        if (ui > 0) S.signal(prev_pm, tid);
        if constexpr (FP8) asm volatile("s_nop 15\n\ts_nop 7" ::: "memory");
        E(acc, cur, wr, wc, fr, fq, pre);
#ifdef DUP_EPI
        if constexpr ((DUP_EPI & Epi::EID) != 0) {
#pragma unroll
            for (int a = 0; a < 2; ++a)
#pragma unroll
                for (int b = 0; b < 2; ++b)
#pragma unroll
                    for (int m = 0; m < 4; ++m)
#pragma unroll
                        for (int n = 0; n < 2; ++n) asm volatile("" : "+v"(acc[a][b][m][n]));
            E(acc, cur, wr, wc, fr, fq, pre);
        }
#endif
        if (!has_next) break;
        E.init(acc, pre);
        prev_pm = cur.pm; cur = nxt; cA = nA; cB = nB; ++ui;
        if (wr == 1) PG8_BAR;
    }
    PG8_WAIT_V(0);
    PG8_BAR;
    S.signal(cur.pm, tid);
#undef PG8_SA
#undef PG8_SB
#undef PG8_STAGE
#undef PG8_STAGE_A
#undef PG8_STAGE_X
#undef PG8_LDA
#undef PG8_LDB
#undef PG8_MMA
#undef PG8_LD8
#undef PG8_HALF
#undef PG8_WAIT_V
#undef PG8_NEXT
#undef PG8_WAIT_VX
#undef PG8_WAIT_L
#undef PG8_BAR
#undef PG8_SCHED
}
}

#include <hip/hip_bf16.h>
namespace attn_body {
using bf16=__hip_bfloat16;
using bf16x8=__attribute__((ext_vector_type(8)))short;
using s16x4=__attribute__((ext_vector_type(4)))short;
using f32x16=__attribute__((ext_vector_type(16)))float;
using u32x4=__attribute__((ext_vector_type(4)))unsigned;
constexpr int BATCH=8,NHEAD=16,SEQ=4096,D=64,DM=NHEAD*D,KP=256;
constexpr int NW=8,QBLK=32,QB=QBLK*NW,KVBLK=64,NQB=SEQ/QB;
constexpr int ATTN_PITCH=DM, ATTN_UNIT_ROWS=QB;
__device__ __forceinline__ int crow(int r,int hi){return (r&3)+8*(r>>2)+4*hi;}
#define SBAR() __builtin_amdgcn_sched_barrier(0)
__device__ __forceinline__ void cmask(f32x16&p0,f32x16&p1,int jb,int qrel,int hi){
  const float NEG=-INFINITY; int kb=64*jb+4*hi;
  #pragma unroll
  for(int r=0;r<16;++r){int kv=kb+(r&3)+8*(r>>2); if(kv>qrel)p0[r]=NEG; if(kv+32>qrel)p1[r]=NEG;}
}

constexpr int NSLOT=3, SLOTB=8192;
constexpr int LDS_K=0, LDS_V=NSLOT*SLOTB, LDS_WS=2*NSLOT*SLOTB, LDS_OST=LDS_WS+NW*64*4, LDS_BYTES=LDS_OST+NW*4096;
constexpr float C2=0.125f*1.4426950408889634f;
__device__ __forceinline__ void glds16(const void*gsrc,unsigned lds_dst){unsigned keep;
  asm volatile("s_mov_b32 %0, m0\n\ts_mov_b32 m0, %2\n\ts_nop 0\n\tglobal_load_lds_dwordx4 %1, off\n\ts_mov_b32 m0, %0":"=&s"(keep):"v"(gsrc),"s"(lds_dst):"memory");}
__device__ __forceinline__ float max3f(float a,float b,float c){float r;asm("v_max3_f32 %0, %1, %2, %3":"=v"(r):"v"(a),"v"(b),"v"(c));return r;}
__device__ __forceinline__ float max2f(float a,float b){float r;asm("v_max_f32_e32 %0, %1, %2":"=v"(r):"v"(a),"v"(b));return r;}
__device__ __forceinline__ float fadd_s(float a,float b){float r;asm("v_add_f32_e32 %0, %1, %2":"=v"(r):"v"(a),"v"(b));return r;}
__device__ __forceinline__ float fsub_s(float a,float b){float r;asm("v_sub_f32_e32 %0, %1, %2":"=v"(r):"v"(a),"v"(b));return r;}
typedef float f32x2_t __attribute__((ext_vector_type(2))); typedef __bf16 bf16x2_t __attribute__((ext_vector_type(2)));
__device__ __forceinline__ unsigned cvtpk_s(float lo,float hi){f32x2_t v={lo,hi};bf16x2_t b=__builtin_convertvector(v,bf16x2_t);return __builtin_bit_cast(unsigned,b);}
#define WAIT_BAR(N) asm volatile("s_waitcnt vmcnt(" #N ") lgkmcnt(0)\n\ts_barrier":::"memory")

__device__ __forceinline__ void qkt(f32x16&p0,f32x16&p1,const char*Kslot,const bf16x8*qr,const f32x16&negm,int r32,int hi){
  const char*kb=Kslot+hi*1024+r32*16;
  #pragma unroll
  for(int d0=0;d0<4;++d0){
    const bf16x8 b0=*reinterpret_cast<const bf16x8*>(kb+d0*2048);
    const bf16x8 b1=*reinterpret_cast<const bf16x8*>(kb+d0*2048+512);
    if(d0==0){p0=__builtin_amdgcn_mfma_f32_32x32x16_bf16(b0,qr[0],negm,0,0,0);p1=__builtin_amdgcn_mfma_f32_32x32x16_bf16(b1,qr[0],negm,0,0,0);}
    else{p0=__builtin_amdgcn_mfma_f32_32x32x16_bf16(b0,qr[d0],p0,0,0,0);p1=__builtin_amdgcn_mfma_f32_32x32x16_bf16(b1,qr[d0],p1,0,0,0);}}
}
typedef __attribute__((address_space(3))) const char* lds_cptr;
typedef short v4i16_t __attribute__((ext_vector_type(4)));
__device__ __forceinline__ void kload8(bf16x8*kf,lds_cptr kp){
  kf[0]=*(const __attribute__((address_space(3))) bf16x8*)(kp);      kf[1]=*(const __attribute__((address_space(3))) bf16x8*)(kp+512);
  kf[2]=*(const __attribute__((address_space(3))) bf16x8*)(kp+2048); kf[3]=*(const __attribute__((address_space(3))) bf16x8*)(kp+2560);
  kf[4]=*(const __attribute__((address_space(3))) bf16x8*)(kp+4096); kf[5]=*(const __attribute__((address_space(3))) bf16x8*)(kp+4608);
  kf[6]=*(const __attribute__((address_space(3))) bf16x8*)(kp+6144); kf[7]=*(const __attribute__((address_space(3))) bf16x8*)(kp+6656);
}
__device__ __forceinline__ void kload2(bf16x8*kf,lds_cptr kp,int j){ kf[2*j]=*(const __attribute__((address_space(3))) bf16x8*)(kp+j*2048); kf[2*j+1]=*(const __attribute__((address_space(3))) bf16x8*)(kp+j*2048+512); }
__device__ __forceinline__ s16x4 vtr(lds_cptr p){ return __builtin_bit_cast(s16x4,__builtin_amdgcn_ds_read_tr16_b64_v4i16((__attribute__((address_space(3))) v4i16_t*)p)); }
__device__ __forceinline__ float rowmax(const f32x16&p0,const f32x16&p1){
  float a=max3f(p0[0],p0[1],p1[0]),b=max3f(p0[2],p0[3],p1[1]);a=max3f(a,p1[2],p1[3]);
  #pragma unroll
  for(int r=4;r<16;r+=4){a=max3f(a,p0[r],p0[r+1]);b=max3f(b,p0[r+2],p0[r+3]);a=max3f(a,p1[r],p1[r+1]);b=max3f(b,p1[r+2],p1[r+3]);}
  const float m=max2f(a,b);
  auto rr=__builtin_amdgcn_permlane32_swap(__float_as_uint(m),__float_as_uint(m),false,false);
  return max2f(__uint_as_float(rr[0]),__uint_as_float(rr[1]));
}
__device__ __forceinline__ void pv(f32x16*o,int vb,bf16x8 pa0,bf16x8 pa1,bf16x8 pa2,bf16x8 pa3){
  #pragma unroll
  for(int d0=0;d0<2;++d0){s16x4 lo[4],hi[4];
    #pragma unroll
    for(int ks=0;ks<4;++ks){
      asm volatile("ds_read_b64_tr_b16 %0,%1 offset:%c2":"=&v"(lo[ks]):"v"(vb),"i"(d0*4096+ks*1024):"memory");
      asm volatile("ds_read_b64_tr_b16 %0,%1 offset:%c2":"=&v"(hi[ks]):"v"(vb),"i"(d0*4096+ks*1024+512):"memory");}
    asm volatile("s_waitcnt lgkmcnt(0)":::"memory");SBAR();
    #define PK(k) (bf16x8){lo[k][0],lo[k][1],lo[k][2],lo[k][3],hi[k][0],hi[k][1],hi[k][2],hi[k][3]}
    o[d0]=__builtin_amdgcn_mfma_f32_32x32x16_bf16(pa0,PK(0),o[d0],0,0,0);
    o[d0]=__builtin_amdgcn_mfma_f32_32x32x16_bf16(pa1,PK(1),o[d0],0,0,0);
    o[d0]=__builtin_amdgcn_mfma_f32_32x32x16_bf16(pa2,PK(2),o[d0],0,0,0);
    o[d0]=__builtin_amdgcn_mfma_f32_32x32x16_bf16(pa3,PK(3),o[d0],0,0,0);
    #undef PK
  }
}

#ifndef ATTN_STORE16
#define ATTN_STORE16(p,v) (*(u32x4*)(p)=(v))
#endif
template<int THRL> __device__ __forceinline__ void attn_unit(int b,int h,int qb,const bf16*Q,const bf16*__restrict__ K,const bf16*__restrict__ V,bf16*O,char*shm,const int tid,const float m0){
  const int lane=tid&63,r32=lane&31,hi=lane>>5; const int wid=__builtin_amdgcn_readfirstlane(tid>>6);
  const long rowbase=(long)b*SEQ; const int q0=qb*QB;
  const bf16*Qw=Q+(rowbase+q0+wid*QBLK)*DM+h*D;
  const bf16*Kh=K+rowbase*KP+(h>>2)*D,*Vh=V+rowbase*KP+(h>>2)*D;
  const unsigned lds0=(unsigned)(uintptr_t)shm;
  float*wsf=(float*)(shm+LDS_WS)+wid*64;
  const bf16*ksrc=Kh+(long)lane*KP+wid*8;
  const bf16*vsrc=Vh+(long)(16*(wid&3)+(lane>>2))*KP+(wid>>2)*32+(lane&3)*8;
  const unsigned kdst=lds0+LDS_K+wid*1024, vdst=lds0+LDS_V+wid*1024;
  #define DMA_K(t,slot) glds16(ksrc+(long)(t)*KVBLK*KP,(unsigned)__builtin_amdgcn_readfirstlane(kdst+(slot)))
  #define DMA_V(t,slot) glds16(vsrc+(long)(t)*KVBLK*KP,(unsigned)__builtin_amdgcn_readfirstlane(vdst+(slot)))
  const int vb0=(int)(lds0+LDS_V)+((lane>>4)&1)*32+(lane&3)*8+(4*hi+((lane&15)>>2))*64;
  const char*Kbase=shm+LDS_K; bf16x8 kf[8];
  const lds_cptr shm3=(lds_cptr)shm; const lds_cptr kp0=shm3+LDS_K+hi*1024+r32*16; const lds_cptr vp0=shm3+LDS_V+((lane>>4)&1)*32+(lane&3)*8+(4*hi+((lane&15)>>2))*64;
  constexpr int NT=SEQ/KVBLK;
  DMA_K(0,0);DMA_V(0,0);DMA_K(1,SLOTB);
  bf16x8 qr[4];
  #pragma unroll
  for(int d0=0;d0<4;++d0)qr[d0]=*reinterpret_cast<const bf16x8*>(&Qw[(long)r32*DM+d0*16+hi*8]);
  float l_reg=0.f;float zf=0.f;asm volatile("":"+v"(zf));f32x16 o[2];
  #pragma unroll
  for(int r=0;r<16;++r){o[0][r]=zf;o[1][r]=zf;}
  f32x16 negm;
  #pragma unroll
  for(int r=0;r<16;++r)negm[r]=zf-m0;
  asm volatile("":"+v"(negm));
  const int qrel=wid*QBLK+r32;
  #define CMASK(P0,P1,t) do{}while(0)
  #define START(P0,P1) do{ _Pragma("unroll") for(int r=0;r<16;++r)P0[r]=__builtin_amdgcn_exp2f(P0[r]); }while(0)
  #define RESC() do{}while(0)
  f32x16 pA0,pA1,pB0,pB1;
  int sl_prev=0,sl_cur=0,sl_next=SLOTB;
  #define ROT() do{sl_prev=sl_cur;sl_cur=sl_next;sl_next=(sl_next==(NSLOT-1)*SLOTB)?0:sl_next+SLOTB;}while(0)
  DMA_K(2,2*SLOTB);
  WAIT_BAR(3);
  qkt(pA0,pA1,Kbase,qr,negm,r32,hi);asm volatile("s_nop 15\n\ts_nop 7":"+v"(pA0),"+v"(pA1));CMASK(pA0,pA1,0);
  START(pA0,pA1);
  _Pragma("unroll") for(int r=0;r<16;++r)pA1[r]=__builtin_amdgcn_exp2f(pA1[r]);
  WAIT_BAR(0);
  DMA_K(3,0);DMA_V(1,SLOTB);
  ROT();
  kload8(kf,kp0+sl_cur);
  WAIT_BAR(2);
  s16x4 vlo[8],vhi[8]; u32x4 pw0,pw1,pw2,pw3;
  #define PKW(P,B) cvtpk_s(P[B],P[B+1])
  #define PAF(k) __builtin_bit_cast(bf16x8,pw##k)
  #define VFR(i) (bf16x8){vlo[i][0],vlo[i][1],vlo[i][2],vlo[i][3],vhi[i][0],vhi[i][1],vhi[i][2],vhi[i][3]}
  #define PIN(x) asm volatile("":"+v"(x))
  #define MX3(a,b,c) __builtin_fmaxf(__builtin_fmaxf((a),(b)),(c))
  #define GAPA(MF,A0,A1,A2,A3,W0,W1,PW) do{ MF; sacc+=A0; sacc+=A1; sacc+=A2; sacc+=A3; PIN(sacc); W0; W1; PIN(PW); SBAR(); }while(0)
  #define EX(v) __builtin_amdgcn_exp2f(v)
  #define GAPB(MF,X,B) do{ MF; X[B]=EX(X[B]); X[B+1]=EX(X[B+1]); X[B+2]=EX(X[B+2]); X[B+3]=EX(X[B+3]); PIN(X); SBAR(); }while(0)
  #define VRD(i) do{ vlo[i]=vtr(vp_+(((i)>>2)*4096+((i)&3)*1024)); vhi[i]=vtr(vp_+(((i)>>2)*4096+((i)&3)*1024+512)); }while(0)
  #define KRD(G,j) do{ if(G){ kload2(kf,kp0+sl_next,j); SBAR(); } }while(0)
  #define STEP(C0,C1,P0,P1,t,GK,GV,GL) do{ SBAR(); \
    const lds_cptr vp_=vp0+sl_prev; \
    VRD(0); SBAR(); float sacc=(P0[0]+P0[1]); \
    GAPA(C0=__builtin_amdgcn_mfma_f32_32x32x16_bf16(kf[0],qr[0],negm,0,0,0), P0[2],P0[3],P0[4],P0[5],     pw0[0]=PKW(P0,0), pw0[1]=PKW(P0,2), pw0); \
    VRD(4); SBAR(); GAPA(C1=__builtin_amdgcn_mfma_f32_32x32x16_bf16(kf[1],qr[0],negm,0,0,0), P0[6],P0[7],P0[8],P0[9],     pw0[2]=PKW(P0,4), pw0[3]=PKW(P0,6), pw0); \
    VRD(1); SBAR(); GAPA(C0=__builtin_amdgcn_mfma_f32_32x32x16_bf16(kf[2],qr[1],C0,0,0,0),   P0[10],P0[11],P0[12],P0[13], pw1[0]=PKW(P0,8), pw1[1]=PKW(P0,10), pw1); \
    VRD(5); SBAR(); GAPA(C1=__builtin_amdgcn_mfma_f32_32x32x16_bf16(kf[3],qr[1],C1,0,0,0),   P0[14],P0[15],P1[0],P1[1],   pw1[2]=PKW(P0,12),pw1[3]=PKW(P0,14), pw1); \
    VRD(2); SBAR(); GAPA(C0=__builtin_amdgcn_mfma_f32_32x32x16_bf16(kf[4],qr[2],C0,0,0,0),   P1[2],P1[3],P1[4],P1[5],     pw2[0]=PKW(P1,0), pw2[1]=PKW(P1,2), pw2); \
    VRD(6); SBAR(); GAPA(C1=__builtin_amdgcn_mfma_f32_32x32x16_bf16(kf[5],qr[2],C1,0,0,0),   P1[6],P1[7],P1[8],P1[9],     pw2[2]=PKW(P1,4), pw2[3]=PKW(P1,6), pw2); \
    VRD(3); SBAR(); GAPA(C0=__builtin_amdgcn_mfma_f32_32x32x16_bf16(kf[6],qr[3],C0,0,0,0),   P1[10],P1[11],P1[12],P1[13], pw3[0]=PKW(P1,8), pw3[1]=PKW(P1,10), pw3); \
    VRD(7); SBAR(); GAPA(C1=__builtin_amdgcn_mfma_f32_32x32x16_bf16(kf[7],qr[3],C1,0,0,0),   P1[14],P1[15],0.f,0.f,       pw3[2]=PKW(P1,12),pw3[3]=PKW(P1,14), pw3); \
    l_reg+=sacc; \
    if(GK){DMA_K((t)+3,sl_cur);} if(GV){DMA_V((t)+1,sl_next);} \
    CMASK(C0,C1,t); \
    SBAR(); \
    GAPB(o[0]=__builtin_amdgcn_mfma_f32_32x32x16_bf16(PAF(0),VFR(0),o[0],0,0,0), C0,0); \
    GAPB(o[1]=__builtin_amdgcn_mfma_f32_32x32x16_bf16(PAF(0),VFR(4),o[1],0,0,0), C0,4); \
    KRD(GL,0); GAPB(o[0]=__builtin_amdgcn_mfma_f32_32x32x16_bf16(PAF(1),VFR(1),o[0],0,0,0), C0,8); \
    KRD(GL,1); GAPB(o[1]=__builtin_amdgcn_mfma_f32_32x32x16_bf16(PAF(1),VFR(5),o[1],0,0,0), C0,12); \
    KRD(GL,2); GAPB(o[0]=__builtin_amdgcn_mfma_f32_32x32x16_bf16(PAF(2),VFR(2),o[0],0,0,0), C1,0); \
    KRD(GL,3); GAPB(o[1]=__builtin_amdgcn_mfma_f32_32x32x16_bf16(PAF(2),VFR(6),o[1],0,0,0), C1,4); \
    GAPB(o[0]=__builtin_amdgcn_mfma_f32_32x32x16_bf16(PAF(3),VFR(3),o[0],0,0,0), C1,8); \
    GAPB(o[1]=__builtin_amdgcn_mfma_f32_32x32x16_bf16(PAF(3),VFR(7),o[1],0,0,0), C1,12); \
    }while(0)
  int t=1;
  #undef CMASK
  #define CMASK(P0,P1,t) do{}while(0)
  for(;t+5<NT;t+=2){
    STEP(pB0,pB1,pA0,pA1,t,true,true,true);     WAIT_BAR(2); RESC(); ROT();
    STEP(pA0,pA1,pB0,pB1,t+1,true,true,true);   WAIT_BAR(2); RESC(); ROT();
  }
  #undef CMASK
  #define CMASK(P0,P1,t) do{}while(0)
  #define ENDW(tt) do{ if((tt)+3<NT){WAIT_BAR(2);} else if((tt)+2<NT){WAIT_BAR(1);} else {WAIT_BAR(0);} }while(0)
  for(;t+1<NT;t+=2){
    STEP(pB0,pB1,pA0,pA1,t,(t+3<NT),(t+1<NT),(t+1<NT));       ENDW(t);   RESC(); ROT();
    STEP(pA0,pA1,pB0,pB1,t+1,(t+4<NT),(t+2<NT),(t+2<NT));     ENDW(t+1); RESC(); ROT();
  }
  STEP(pB0,pB1,pA0,pA1,NT-1,false,false,false); RESC();
  { float sacc=pB0[0]+pB0[1]; _Pragma("unroll") for(int r=2;r<16;++r)sacc+=pB0[r]; _Pragma("unroll") for(int r=0;r<16;++r)sacc+=pB1[r]; l_reg+=sacc;
    pw0=(u32x4){PKW(pB0,0),PKW(pB0,2),PKW(pB0,4),PKW(pB0,6)};pw1=(u32x4){PKW(pB0,8),PKW(pB0,10),PKW(pB0,12),PKW(pB0,14)};pw2=(u32x4){PKW(pB1,0),PKW(pB1,2),PKW(pB1,4),PKW(pB1,6)};pw3=(u32x4){PKW(pB1,8),PKW(pB1,10),PKW(pB1,12),PKW(pB1,14)};
    SBAR(); pv(o,vb0+sl_cur,PAF(0),PAF(1),PAF(2),PAF(3)); }
  #undef PKW
  #undef PAF
  #undef VFR
  #undef PIN
  #undef MX3
  #undef GAPA
  #undef GAPB
  #undef EX
  #undef VRD
  #undef KRD
  #undef STEP
  #undef ENDW
  {auto rr=__builtin_amdgcn_permlane32_swap(__float_as_uint(l_reg),__float_as_uint(l_reg),false,false);l_reg=__uint_as_float(rr[0])+__uint_as_float(rr[1]);}
  if(hi==0)wsf[32+r32]=l_reg;asm volatile("s_waitcnt lgkmcnt(0)":::"memory");
  float rli[16];
  #pragma unroll
  for(int r=0;r<16;++r)rli[r]=__builtin_amdgcn_rcpf(wsf[32+crow(r,hi)]);
  unsigned char*Ow=(unsigned char*)O+(rowbase+q0+wid*QBLK)*DM+h*D;
  { unsigned char*stg=(unsigned char*)(shm+LDS_OST)+wid*4096;
    #pragma unroll
    for(int r=0;r<16;++r){const int orow=crow(r,hi); const float sc=rli[r]*64.0f;
      #pragma unroll
      for(int d0=0;d0<2;++d0){const float val=o[d0][r]*sc; stg[orow*64+d0*32+r32]=(unsigned char)(__builtin_amdgcn_cvt_pk_fp8_f32(val,val,0,false)&0xff);}}
    asm volatile("s_waitcnt lgkmcnt(0)":::"memory");
    #pragma unroll
    for(int i=0;i<2;++i){const int row=i*16+(lane>>2),ch=lane&3; const u32x4 v=*(const u32x4*)(stg+row*64+ch*16); ATTN_STORE16(Ow+(long)row*DM+ch*16,v);} }
  asm volatile("s_waitcnt lgkmcnt(0)\n\ts_barrier":::"memory");
  #undef DMA_K
  #undef DMA_V
  #undef CMASK
  #undef START
  #undef RESC
  #undef ROT
}
constexpr int ATTN_LDS_BYTES=LDS_BYTES;
struct AttnTensors { const bf16* Q; const bf16* K; const bf16* V; bf16* O; };
struct AttnUnit { int bh; int qb; };
struct GqaOrder {
  int vcu, G;
  __device__ __forceinline__ GqaOrder(int grid,int block):vcu((grid%8==0)?(block%8)*(grid/8)+block/8:block),G(grid){}
  __device__ __forceinline__ bool next(int i,AttnUnit&u)const{ const int U=i*G+vcu; if(U>=BATCH*NHEAD*NQB)return false; const int pr=U>>6, idx=U&63; u.bh=(pr>>2)*NHEAD+(pr&3)*4+(idx>>4); u.qb=idx&15; return true; }
  __device__ __forceinline__ void a_ready(const AttnUnit&)const{}
  __device__ __forceinline__ void done(const AttnUnit&)const{}
};
template<class Sched,int THRL=8> __device__ __forceinline__ void attn_phase(char*lds,const AttnTensors&T,const Sched&S,const int tid,const float m0){
  AttnUnit u;
  for(int i=0;S.next(i,u);++i){ S.a_ready(u); attn_unit<THRL>(u.bh/NHEAD,u.bh%NHEAD,u.qb,T.Q,T.K,T.V,T.O,lds,tid,m0); S.done(u); }
}
template<int THRL=8,class PFn> __device__ __forceinline__ void attn_phase_dyn(char*lds,const AttnTensors&T,const int tid,const float m0,unsigned*ctr,volatile __attribute__((address_space(3))) unsigned*bw,const int xcd,const int np,PFn pf){
  const int total=256+np;
  #pragma unroll 1
  for(int qo=0;qo<8;++qo){ const int qx=(xcd+qo)&7; unsigned*c=ctr+qx*32;
    unsigned nextp=0; if(tid==0)nextp=__hip_atomic_fetch_add(c,1u,__ATOMIC_RELAXED,__HIP_MEMORY_SCOPE_AGENT);
    #pragma unroll 1
    for(;;){
      __syncthreads(); if(tid==0)*bw=nextp; __syncthreads();
      const int p=__builtin_amdgcn_readfirstlane((int)*bw);
      if(p>=total)break;
      if(tid==0)nextp=__hip_atomic_fetch_add(c,1u,__ATOMIC_RELAXED,__HIP_MEMORY_SCOPE_AGENT);
      int a=p,k=-1;
      if(np){ if(p>=416){k=160+(p-416);} else { const int g=p/13,q=p-13*g;
          const int pc=(q>2)+(q>5)+(q>7)+(q>10)+(q>12);
          if(q==2||q==5||q==7||q==10||q==12){k=5*g+(q==2?0:q==5?1:q==7?2:q==10?3:4);} else a=8*g+(q-pc); } }
      if(k>=0){ pf(qx*np+k); }
      else{ const int U=(a>>5)*256+32*qx+(a&31), pr=U>>6, idx=U&63, bh=(pr>>2)*NHEAD+(pr&3)*4+(idx>>4), qb=idx&15;
        attn_unit<THRL>(bh/NHEAD,bh%NHEAD,qb,T.Q,T.K,T.V,T.O,lds,tid,m0); }
    }
  }
}
#undef SBAR
#undef WAIT_BAR
}

constexpr int T = 32768, D = 1024, SEQ = 4096, NLAYER = 4, NE = 32;
constexpr float LN_EPS = 1e-5f, QK_EPS = 1e-6f;
constexpr float DN_ALPHA = 1.681792830507429f;
constexpr float WGU_SCALE = 64.0f, WDN_SCALE = 128.0f;
constexpr int WGU_E8M0 = 0x79797979, WDN_E8M0 = 0x78787878;

constexpr size_t MiB = 1u << 20;
constexpr size_t WS_CTL = 0, CTL_ZERO_BYTES = 128 * 1024;
constexpr size_t WS_ROPE = 1 * MiB;
constexpr size_t WS_BGU = 2 * MiB;
constexpr size_t WS_WS = 3 * MiB;
constexpr size_t WS_STATS = 4 * MiB;
constexpr size_t WS_GATE = 5 * MiB;
constexpr size_t WS_LIST = 6 * MiB;
constexpr size_t WS_GLIST = 10 * MiB;
constexpr size_t WS_WQKV = 16 * MiB, WS_WO = 22 * MiB, WS_GIN = 26 * MiB, WS_GOUT = 34 * MiB, WS_CIN = 38 * MiB, WS_COUT = 44 * MiB;
constexpr size_t WS_WGU = 64 * MiB;
constexpr size_t WS_WDN = 320 * MiB;
constexpr size_t WS_XB = 448 * MiB;
constexpr size_t WS_X8 = 512 * MiB;
constexpr size_t WS_HB = 544 * MiB;
constexpr size_t WS_MIX = 608 * MiB;
constexpr size_t WS_HM = 992 * MiB;
constexpr size_t WS_Y = 1136 * MiB;
constexpr size_t WS_END = 1393 * MiB;
constexpr int CW_BAR = 4096;
constexpr int CW_RDY2 = 29440;
constexpr int CW_RDY = 26624;
constexpr int CW_QUE = 24576;
constexpr int CW_CNT = 16384;

constexpr int RING_OFF = 0, RING_BYTES = 131072;
constexpr int LDSCTL_OFF = 139264;
constexpr int MISC_OFF = LDSCTL_OFF;
constexpr int MOE_OFF = LDSCTL_OFF + 256;
constexpr int SEL_OFF = LDSCTL_OFF + 1024;
constexpr int LDS_BYTES = 147456;

#define GAS __attribute__((address_space(1)))
#define LAS __attribute__((address_space(3)))
typedef unsigned short bf16;
typedef unsigned v4u __attribute__((ext_vector_type(4)));
typedef unsigned v2u __attribute__((ext_vector_type(2)));
typedef float f32x4 __attribute__((ext_vector_type(4)));
typedef float f32x2v __attribute__((ext_vector_type(2)));
typedef GAS unsigned char* gptr;
#define LDS_WAIT() asm volatile("s_waitcnt lgkmcnt(0)" ::: "memory")
#define VM_WAIT() asm volatile("s_waitcnt vmcnt(0)" ::: "memory")
__device__ __forceinline__ unsigned f2bf(float f) { unsigned u = __builtin_bit_cast(unsigned, f); return (u + 0x7fffu + ((u >> 16) & 1u)) >> 16; }
__device__ __forceinline__ unsigned pk2(float lo, float hi) { return f2bf(lo) | (f2bf(hi) << 16); }
__device__ __forceinline__ float bflo(unsigned w) { return __builtin_bit_cast(float, w << 16); }
__device__ __forceinline__ float bfhi(unsigned w) { return __builtin_bit_cast(float, w & 0xffff0000u); }
__device__ __forceinline__ unsigned pk4f8(float a, float b, float c, float d) { int w = 0; w = __builtin_amdgcn_cvt_pk_fp8_f32(a, b, w, false); w = __builtin_amdgcn_cvt_pk_fp8_f32(c, d, w, true); return (unsigned)w; }
__device__ __forceinline__ void unpack8(const v4u w, float (&x)[8]) { x[0] = bflo(w.x); x[1] = bfhi(w.x); x[2] = bflo(w.y); x[3] = bfhi(w.y); x[4] = bflo(w.z); x[5] = bfhi(w.z); x[6] = bflo(w.w); x[7] = bfhi(w.w); }
__device__ __forceinline__ int uni(int v) { return __builtin_amdgcn_readfirstlane(v); }
__device__ __forceinline__ gptr uni(gptr p) { const unsigned long long v = (unsigned long long)p; const unsigned lo = __builtin_amdgcn_readfirstlane((unsigned)v), hi = __builtin_amdgcn_readfirstlane((unsigned)(v >> 32)); return (gptr)(((unsigned long long)hi << 32) | lo); }
#define UNIP(type, p) ((type)uni((gptr)(p)))

#define XB_TMO      128
#define XB_XCNT(j)  (256  + 64 * (j))
#define XB_XSUB(j)  (1280 + 64 * (j))
#define XB_XGEN(j)  (2304 + 64 * (j))
#define XB_TOP      3328
#define XB_TOPGEN   3392
#define XCD_BAR_WORDS 3456
#define XB_SPIN_CAP (1u << 18)

__device__ __forceinline__ unsigned xb_ld(unsigned* p)              { return __hip_atomic_load(p, __ATOMIC_RELAXED, __HIP_MEMORY_SCOPE_AGENT); }
__device__ __forceinline__ unsigned xb_add(unsigned* p, unsigned v) { return __hip_atomic_fetch_add(p, v, __ATOMIC_RELAXED, __HIP_MEMORY_SCOPE_AGENT); }
__device__ __forceinline__ unsigned xb_xcc_id() { return (unsigned)__builtin_amdgcn_s_getreg((3 << 11) | 20) & 0xFu; }
#define XB_SPIN(cond, bar) do { unsigned _sp = 0; while (cond) { __builtin_amdgcn_s_sleep(1); \
    if ((++_sp & 255u) == 0u) { if (xb_ld(&(bar)[XB_TMO])) break; if (_sp > XB_SPIN_CAP) { atomicAdd(&(bar)[XB_TMO], 1u); break; } } } } while (0)

struct XcdBarrier {
    unsigned* bar; unsigned x; int wave;
    volatile LAS unsigned* st;
};

__device__ __forceinline__ XcdBarrier xcd_barrier_post(unsigned* bar, volatile LAS unsigned* st) {
    XcdBarrier b; b.bar = bar; b.x = xb_xcc_id(); b.st = st;
    if (threadIdx.x == 0) st[2] = xb_add(&bar[XB_XCNT(b.x)], 1u);
    return b;
}
__device__ __forceinline__ void xcd_barrier_complete(unsigned* bar, unsigned x, unsigned& nloc, unsigned& nx, unsigned& pre) {
    const unsigned G = gridDim.x * gridDim.y * gridDim.z;
    unsigned sum, cnt, mine, below, sp = 0u;
    for (;;) {
        sum = 0u; cnt = 0u; mine = 0u; below = 0u;
#pragma unroll
        for (unsigned j = 0; j < 16; ++j) { const unsigned c = xb_ld(&bar[XB_XCNT(j)]); sum += c; cnt += (c > 0u) ? 1u : 0u; mine = (j == x) ? c : mine; below += (j < x) ? c : 0u; }
        if (sum == G) break;
        __builtin_amdgcn_s_sleep(1);
        if ((++sp & 255u) == 0u) { if (xb_ld(&bar[XB_TMO])) break; if (sp > XB_SPIN_CAP) { atomicAdd(&bar[XB_TMO], 1u); break; } }
    }
    nloc = mine > 0u ? mine : 1u; nx = cnt > 0u ? cnt : 1u; pre = below;
}

__device__ __forceinline__ void xcd_barrier(const XcdBarrier& b) {
    asm volatile("s_waitcnt vmcnt(0)" ::: "memory");
    __syncthreads();
    int xb_lane_; asm volatile("v_mbcnt_lo_u32_b32 %0, -1, 0\n\tv_mbcnt_hi_u32_b32 %0, -1, %0" : "=v"(xb_lane_));
    if (b.wave == 0 && xb_lane_ == 0) {
        unsigned* bar = b.bar;
        __builtin_amdgcn_s_waitcnt(0);
        unsigned nloc = b.st[0], nx = b.st[1];
        if (nloc == 0u) { unsigned pre_; xcd_barrier_complete(bar, b.x, nloc, nx, pre_); b.st[0] = nloc; b.st[1] = nx; b.st[3] = pre_; }
        const unsigned old = xb_add(&bar[XB_XSUB(b.x)], 1u);
        const unsigned gen = old / nloc;
        if (old + 1u == (gen + 1u) * nloc) {
            __builtin_amdgcn_fence(__ATOMIC_RELEASE, "agent");
            asm volatile("s_waitcnt vmcnt(0)" ::: "memory");
            const unsigned og = xb_add(&bar[XB_TOP], 1u);
            const unsigned tg = og / nx;
            if (og + 1u == (tg + 1u) * nx) xb_add(&bar[XB_TOPGEN], 1u);
            else XB_SPIN(xb_ld(&bar[XB_TOPGEN]) == tg, bar);
            __builtin_amdgcn_fence(__ATOMIC_ACQUIRE, "agent");
            xb_add(&bar[XB_XGEN(b.x)], 1u);
            asm volatile("s_waitcnt vmcnt(0)" ::: "memory");
        } else {
            XB_SPIN(xb_ld(&bar[XB_XGEN(b.x)]) == gen, bar);
            __builtin_amdgcn_fence(__ATOMIC_ACQUIRE, "agent");
            asm volatile("s_waitcnt vmcnt(0)" ::: "memory");
        }
    }
    __syncthreads();
}


__device__ __forceinline__ float wave_sum(float v) {
#pragma unroll
    for (int o = 1; o < 64; o <<= 1) v += __shfl_xor(v, o);
    return v;
}
struct TC { int lane, wave, G, vcu; };
__device__ __forceinline__ TC mk_tc(int wave) { TC c; int lane; asm volatile("v_mbcnt_lo_u32_b32 %0, -1, 0\n\tv_mbcnt_hi_u32_b32 %0, -1, %0" : "=v"(lane)); c.lane = lane; c.wave = wave; c.G = gridDim.x; const int bx = blockIdx.x; c.vcu = (c.G % 8 == 0) ? (bx % 8) * (c.G / 8) + bx / 8 : bx; return c; }
#define TC_UNPACK() extern __shared__ __attribute__((aligned(16))) unsigned char lds_raw[]; LAS unsigned char* const lds = (LAS unsigned char*)lds_raw; (void)lds; \
    const int lane = c_.lane, wave = uni(c_.wave), G = uni(c_.G), vcu = uni(c_.vcu), tid = wave * 64 + lane, gw = vcu * 8 + wave, NGW = G * 8; (void)tid; (void)gw; (void)NGW

__device__ __forceinline__ void sincos_d(double a, float& c, float& s) {
    const double k = __builtin_rint(a * 0.63661977236758134); const double r = a - k * 1.5707963267948966192; const double r2 = r * r;
    const double sn = r * (1.0 + r2 * (-1.0 / 6 + r2 * (1.0 / 120 + r2 * (-1.0 / 5040 + r2 * (1.0 / 362880 + r2 * (-1.0 / 39916800 + r2 * (1.0 / 6227020800.0)))))));
    const double cn = 1.0 + r2 * (-0.5 + r2 * (1.0 / 24 + r2 * (-1.0 / 720 + r2 * (1.0 / 40320 + r2 * (-1.0 / 3628800 + r2 * (1.0 / 479001600 + r2 * (-1.0 / 87178291200.0)))))));
    const int q = ((int)k) & 3;
    const double sv = (q == 0) ? sn : (q == 1) ? cn : (q == 2) ? -sn : -cn;
    const double cv = (q == 0) ? cn : (q == 1) ? -sn : (q == 2) ? -cn : sn;
    c = (float)cv; s = (float)sv;
}
template <int MODE, bool B16, bool NT = false> __device__ __forceinline__ void p0_item(const GAS float* W, int K, int N, gptr WT, float scale, LAS float* scr, int item, int lane) {
    const int nblk = N / 64, kb = item / nblk, nb = item % nblk, k0 = 64 * kb, n0 = 64 * nb;
    const int lr = lane >> 4, lc = (lane & 15) * 4;
    if constexpr (B16) { f32x4 vv[16];
#pragma unroll
        for (int i = 0; i < 16; ++i) { const GAS f32x4* p_ = (const GAS f32x4*)(W + (size_t)(k0 + 4 * i + lr) * N + n0 + lc); vv[i] = NT ? __builtin_nontemporal_load(p_) : *p_; }
#pragma unroll
        for (int i = 0; i < 16; ++i) { const int kk = 4 * i + lr; scr[kk * 65 + lc] = vv[i].x; scr[kk * 65 + lc + 1] = vv[i].y; scr[kk * 65 + lc + 2] = vv[i].z; scr[kk * 65 + lc + 3] = vv[i].w; }
    } else {
#pragma unroll 4
        for (int i = 0; i < 16; ++i) { const int kk = 4 * i + lr; const f32x4 v = *(const GAS f32x4*)(W + (size_t)(k0 + kk) * N + n0 + lc);
            scr[kk * 65 + lc] = v.x; scr[kk * 65 + lc + 1] = v.y; scr[kk * 65 + lc + 2] = v.z; scr[kk * 65 + lc + 3] = v.w; } }
    LDS_WAIT(); asm volatile("" ::: "memory");
    if (MODE == 0) {
        const int c = lane & 7;
#pragma unroll
        for (int j = 0; j < 8; ++j) { const int nl = (lane >> 3) + 8 * j; const LAS float* s = scr + (8 * c) * 65 + nl;
            v4u o; o.x = pk2(s[0 * 65], s[1 * 65]); o.y = pk2(s[2 * 65], s[3 * 65]); o.z = pk2(s[4 * 65], s[5 * 65]); o.w = pk2(s[6 * 65], s[7 * 65]);
            *(GAS v4u*)(WT + ((size_t)(n0 + nl) * K + k0 + 8 * c) * 2) = o; }
    } else {
        const int c = lane & 3;
#pragma unroll
        for (int j = 0; j < 4; ++j) { const int nl = (lane >> 2) + 16 * j; const LAS float* s = scr + (16 * c) * 65 + nl;
            v4u o; o.x = pk4f8(s[0 * 65] * scale, s[1 * 65] * scale, s[2 * 65] * scale, s[3 * 65] * scale); o.y = pk4f8(s[4 * 65] * scale, s[5 * 65] * scale, s[6 * 65] * scale, s[7 * 65] * scale);
            o.z = pk4f8(s[8 * 65] * scale, s[9 * 65] * scale, s[10 * 65] * scale, s[11 * 65] * scale); o.w = pk4f8(s[12 * 65] * scale, s[13 * 65] * scale, s[14 * 65] * scale, s[15 * 65] * scale);
            const int n = n0 + nl; int row = n; if (MODE == 1) { const int jj = n >> 1; row = (jj >> 7) * 256 + (n & 1) * 128 + (jj & 127); }
            GAS v4u* q_ = (GAS v4u*)(WT + (size_t)row * K + k0 + 16 * c); if (NT) __builtin_nontemporal_store(o, q_); else *q_ = o; }
    }
    LDS_WAIT(); asm volatile("" ::: "memory");
}
template <bool NT> __device__ __forceinline__ void p0_load(f32x4 (&vv)[16], const GAS float* W, int N, int item, int lane) {
    const int nblk = N / 64, kb = item / nblk, nb = item % nblk, k0 = 64 * kb, n0 = 64 * nb; const int lr = lane >> 4, lc = (lane & 15) * 4;
#pragma unroll
    for (int i = 0; i < 16; ++i) { const GAS f32x4* p_ = (const GAS f32x4*)(W + (size_t)(k0 + 4 * i + lr) * N + n0 + lc); vv[i] = NT ? __builtin_nontemporal_load(p_) : *p_; }
}
__device__ __forceinline__ void p0_put(const f32x4 (&vv)[16], LAS float* scr, int lane) {
    const int lr = lane >> 4, lc = (lane & 15) * 4;
#pragma unroll
    for (int i = 0; i < 16; ++i) { const int kk = 4 * i + lr; scr[kk * 65 + lc] = vv[i].x; scr[kk * 65 + lc + 1] = vv[i].y; scr[kk * 65 + lc + 2] = vv[i].z; scr[kk * 65 + lc + 3] = vv[i].w; }
}
template <int MODE, bool NT> __device__ __forceinline__ void p0_out(const LAS float* scr, int K, int N, gptr WT, float scale, int item, int lane) {
    const int nblk = N / 64, kb = item / nblk, nb = item % nblk, k0 = 64 * kb, n0 = 64 * nb;
    const int c = lane & 3;
#pragma unroll
    for (int j = 0; j < 4; ++j) { const int nl = (lane >> 2) + 16 * j; const LAS float* s = scr + (16 * c) * 65 + nl;
        v4u o; o.x = pk4f8(s[0 * 65] * scale, s[1 * 65] * scale, s[2 * 65] * scale, s[3 * 65] * scale); o.y = pk4f8(s[4 * 65] * scale, s[5 * 65] * scale, s[6 * 65] * scale, s[7 * 65] * scale);
        o.z = pk4f8(s[8 * 65] * scale, s[9 * 65] * scale, s[10 * 65] * scale, s[11 * 65] * scale); o.w = pk4f8(s[12 * 65] * scale, s[13 * 65] * scale, s[14 * 65] * scale, s[15 * 65] * scale);
        const int n = n0 + nl; int row = n; if (MODE == 1) { const int jj = n >> 1; row = (jj >> 7) * 256 + (n & 1) * 128 + (jj & 127); }
        GAS v4u* q_ = (GAS v4u*)(WT + (size_t)row * K + k0 + 16 * c); if (NT) __builtin_nontemporal_store(o, q_); else *q_ = o; }
}
#define P0_JOB(MODE_, srcp, K_, N_, NMAT_, DST_, ES_, SC_) do { constexpr int per = ((K_) / 64) * ((N_) / 64), n_items = per * (NMAT_); \
        _Pragma("unroll 1") for (int it = gw; it < n_items; it += NGW) { const int mat = it / per, r = it % per; \
            p0_item<MODE_, ((NMAT_) > 8)>((srcp) + (size_t)mat * (K_) * (N_), (K_), (N_), ws + (DST_) + (size_t)mat * (K_) * (N_) * (ES_), (SC_), scr, r, lane); } } while (0)
__device__ __noinline__ void p0_experts(TC c_, gptr ws_, const GAS float* wgu_, const GAS float* wdn_) {
    TC_UNPACK(); gptr ws = uni(ws_); const GAS float* wgu = UNIP(const GAS float*, wgu_); const GAS float* wdn = UNIP(const GAS float*, wdn_);
    LAS float* scr = (LAS float*)(lds + RING_OFF + wave * 16640);
    P0_JOB(1, wgu, 1024, 2048, 128, WS_WGU, 1, WGU_SCALE);
    P0_JOB(2, wdn, 1024, 1024, 128, WS_WDN, 1, WDN_SCALE);
}
#ifndef P0_NT
#define P0_NT true
#endif
__device__ __noinline__ void p0_chunk(TC c_, gptr ws_, const GAS float* wgu_, const GAS float* wdn_, int chunk_) {
    TC_UNPACK(); gptr ws = uni(ws_); const GAS float* wgu = UNIP(const GAS float*, wgu_); const GAS float* wdn = UNIP(const GAS float*, wdn_); const int chunk = uni(chunk_);
    LAS float* scr = (LAS float*)(lds + RING_OFF + wave * 16640);
    f32x4 vv[16];
    if (chunk < 1024) { const int it0 = chunk * 64 + wave;
        p0_load<P0_NT>(vv, wgu + (size_t)(it0 >> 9) * 1024 * 2048, 2048, it0 & 511, lane);
#pragma unroll 1
        for (int j = 0; j < 8; ++j) { const int it = it0 + j * 8, itn = it + 8;
            p0_put(vv, scr, lane);
            if (j < 7) p0_load<P0_NT>(vv, wgu + (size_t)(itn >> 9) * 1024 * 2048, 2048, itn & 511, lane);
            LDS_WAIT(); asm volatile("" ::: "memory");
            p0_out<1, P0_NT>(scr, 1024, 2048, ws + WS_WGU + (size_t)(it >> 9) * 1024 * 2048, WGU_SCALE, it & 511, lane);
            LDS_WAIT(); asm volatile("" ::: "memory"); }
    } else { const int it0 = (chunk - 1024) * 64 + wave;
        p0_load<P0_NT>(vv, wdn + (size_t)(it0 >> 8) * 1024 * 1024, 1024, it0 & 255, lane);
#pragma unroll 1
        for (int j = 0; j < 8; ++j) { const int it = it0 + j * 8, itn = it + 8;
            p0_put(vv, scr, lane);
            if (j < 7) p0_load<P0_NT>(vv, wdn + (size_t)(itn >> 8) * 1024 * 1024, 1024, itn & 255, lane);
            LDS_WAIT(); asm volatile("" ::: "memory");
            p0_out<2, P0_NT>(scr, 1024, 1024, ws + WS_WDN + (size_t)(it >> 8) * 1024 * 1024, WDN_SCALE, it & 255, lane);
            LDS_WAIT(); asm volatile("" ::: "memory"); }
    }
}
__device__ __noinline__ void p0_dense(TC c_, gptr ws_, const GAS float* wqkv_, const GAS float* wo_, const GAS float* gin_, const GAS float* gout_, const GAS float* cin_, const GAS float* cout_) {
    TC_UNPACK(); gptr ws = uni(ws_);
    const GAS float* wqkv = UNIP(const GAS float*, wqkv_); const GAS float* wo = UNIP(const GAS float*, wo_); const GAS float* gin = UNIP(const GAS float*, gin_);
    const GAS float* gout = UNIP(const GAS float*, gout_); const GAS float* cin = UNIP(const GAS float*, cin_); const GAS float* cout = UNIP(const GAS float*, cout_);
    LAS float* scr = (LAS float*)(lds + RING_OFF + wave * 16640);
    P0_JOB(2, wqkv, 1024, 1536, 2, WS_WQKV, 1, WGU_SCALE);
    P0_JOB(2, wo, 1024, 1024, 2, WS_WO, 1, WDN_SCALE);
    P0_JOB(2, gin, 1024, 4096, 1, WS_GIN, 1, WGU_SCALE);
    P0_JOB(2, gout, 2048, 1024, 1, WS_GOUT, 1, WDN_SCALE);
    P0_JOB(0, cin, 1024, 3072, 1, WS_CIN, 2, 1.0f);
    P0_JOB(2, cout, 1024, 1024, 1, WS_COUT, 1, WDN_SCALE);
}
#undef P0_JOB
__device__ __noinline__ void p0_misc(TC c_, gptr ws_, const GAS float* x_, const GAS float* wsp_, const GAS float* bgu_) {
    TC_UNPACK(); gptr ws = uni(ws_); const GAS float* x = UNIP(const GAS float*, x_); const GAS float* w = UNIP(const GAS float*, wsp_); const GAS float* b = UNIP(const GAS float*, bgu_);
    const int gt = gw * 64 + lane, NT_ = NGW * 64;
    { GAS bf16* o = (GAS bf16*)(ws + WS_WS); for (int i = gt; i < 8 * 128 * 128; i += NT_) o[i] = (bf16)f2bf(w[i]); }
    { GAS float* o = (GAS float*)(ws + WS_BGU); for (int i = gt; i < 4 * 32 * 2048; i += NT_) { const int le = i >> 11, cc = i & 2047, pn = cc >> 8, bj = (cc >> 7) & 1, ii = cc & 127; o[i] = b[(size_t)le * 2048 + 2 * (pn * 128 + ii) + bj]; } }
    { GAS f32x2v* o = (GAS f32x2v*)(ws + WS_ROPE); for (int i = gt; i < 4096 * 32; i += NT_) { const int s = i >> 5, p = i & 31; const double pos = (double)((p < 16) ? (s >> 6) : (s & 63));
        const int pi = p & 15, q4 = pi & 3, d4 = pi >> 2;
        const double b4 = q4 == 0 ? 1.0 : q4 == 1 ? 0.5623413251903491 : q4 == 2 ? 0.31622776601683794 : 0.1778279410038923;
        const double sc = d4 == 0 ? 1.0 : d4 == 1 ? 0.1 : d4 == 2 ? 0.01 : 0.001;
        float cv, sv; sincos_d(pos * (b4 * sc), cv, sv); o[i] = (f32x2v){cv, sv}; } }
    { GAS v2u* xb = (GAS v2u*)(ws + WS_XB);
      GAS unsigned* x8 = (GAS unsigned*)(ws + WS_X8);
      for (size_t i0 = (size_t)gt; i0 < (size_t)T * D / 4; i0 += (size_t)8 * NT_) { f32x4 v[8];
#pragma unroll
          for (int q = 0; q < 8; ++q) { const size_t i = i0 + (size_t)q * NT_; v[q] = (i < (size_t)T * D / 4) ? ((const GAS f32x4*)x)[i] : (f32x4){0.f, 0.f, 0.f, 0.f}; }
#pragma unroll
          for (int q = 0; q < 8; ++q) { const size_t i = i0 + (size_t)q * NT_; if (i < (size_t)T * D / 4) { v2u o; o.x = pk2(v[q].x, v[q].y); o.y = pk2(v[q].z, v[q].w); xb[i] = o; x8[i] = pk4f8(v[q].x, v[q].y, v[q].z, v[q].w); } } } }
}

template <int CTRL, int ROWMASK = 0xF, int BANKMASK = 0xF> __device__ __forceinline__ float dppf(float old, float src) {
    return __builtin_bit_cast(float, __builtin_amdgcn_update_dpp(__builtin_bit_cast(int, old), __builtin_bit_cast(int, src), CTRL, ROWMASK, BANKMASK, false)); }
template <int CTRL, int ROWMASK = 0xF, int BANKMASK = 0xF> __device__ __forceinline__ unsigned dppu(unsigned old, unsigned src) {
    return (unsigned)__builtin_amdgcn_update_dpp((int)old, (int)src, CTRL, ROWMASK, BANKMASK, false); }
__device__ __forceinline__ float wsum(float v) {
    v += dppf<0xB1>(0.f, v); v += dppf<0x4E>(0.f, v); v += dppf<0x141>(0.f, v); v += dppf<0x140>(0.f, v);
    v += dppf<0x142, 0xA>(0.f, v); v += dppf<0x143, 0xC>(0.f, v);
    return __builtin_bit_cast(float, __builtin_amdgcn_readlane(__builtin_bit_cast(int, v), 63));
}
__device__ __forceinline__ unsigned wmaxu(unsigned v) {
    v = max(v, dppu<0xB1>(0u, v)); v = max(v, dppu<0x4E>(0u, v)); v = max(v, dppu<0x141>(0u, v)); v = max(v, dppu<0x140>(0u, v));
    v = max(v, dppu<0x142, 0xA>(0u, v)); v = max(v, dppu<0x143, 0xC>(0u, v));
    return (unsigned)__builtin_amdgcn_readlane((int)v, 63);
}
__device__ __forceinline__ void ld_bf8(const GAS bf16* row, int lane, int j, float (&x)[8]) { const v4u w = ((const GAS v4u*)row)[lane + 64 * j]; x[0] = bflo(w.x); x[1] = bfhi(w.x); x[2] = bflo(w.y); x[3] = bfhi(w.y); x[4] = bflo(w.z); x[5] = bfhi(w.z); x[6] = bflo(w.w); x[7] = bfhi(w.w); }
__device__ __forceinline__ void ln16(float (&v)[16], const float (&g)[16], const float (&b)[16]) {
    float s = 0.f;
#pragma unroll
    for (int i = 0; i < 16; ++i) s += v[i];
    const float mean = wsum(s) * (1.f / D); float s2 = 0.f;
#pragma unroll
    for (int i = 0; i < 16; ++i) { v[i] -= mean; s2 += v[i] * v[i]; }
    const float rstd = 1.f / sqrtf(wsum(s2) * (1.f / D) + LN_EPS);
#pragma unroll
    for (int i = 0; i < 16; ++i) v[i] = v[i] * rstd * g[i] + b[i];
}
__device__ __forceinline__ void ln16_lds(float (&v)[16], const LAS float* gb, int lane) {
    float s = 0.f;
#pragma unroll
    for (int i = 0; i < 16; ++i) s += v[i];
    const float mean = wsum(s) * (1.f / D); float s2 = 0.f;
#pragma unroll
    for (int i = 0; i < 16; ++i) { v[i] -= mean; s2 += v[i] * v[i]; }
    const float rstd = 1.f / sqrtf(wsum(s2) * (1.f / D) + LN_EPS);
#pragma unroll
    for (int j = 0; j < 2; ++j)
#pragma unroll
        for (int h = 0; h < 2; ++h) { const f32x4 gg = *(const LAS f32x4*)(gb + 8 * lane + 512 * j + 4 * h), bb = *(const LAS f32x4*)(gb + 1024 + 8 * lane + 512 * j + 4 * h);
#pragma unroll
            for (int i = 0; i < 4; ++i) v[8 * j + 4 * h + i] = v[8 * j + 4 * h + i] * rstd * gg[i] + bb[i]; }
}
__device__ __forceinline__ float logit_reduce16(const float (&a)[16], int lane) {
    float r8[8], r4[4], r2[2];
#pragma unroll
    for (int i = 0; i < 8; ++i) { const auto rr = __builtin_amdgcn_permlane16_swap(__float_as_uint(a[i]), __float_as_uint(a[8 + i]), false, false); r8[i] = __uint_as_float(rr[0]) + __uint_as_float(rr[1]); }
    { const bool hb = lane & 8;
#pragma unroll
      for (int i = 0; i < 4; ++i) { const float keep = hb ? r8[4 + i] : r8[i], send = hb ? r8[i] : r8[4 + i]; r4[i] = keep + dppf<0x128>(0.f, send); } }
    { const bool hb = lane & 4;
#pragma unroll
      for (int i = 0; i < 2; ++i) { const float keep = hb ? r4[2 + i] : r4[i], send = hb ? r4[i] : r4[2 + i]; float t = dppf<0x104, 0xF, 0x5>(0.f, send); t = dppf<0x114, 0xF, 0xA>(t, send); r2[i] = keep + t; } }
    float r1; { const bool hb = lane & 2; const float keep = hb ? r2[1] : r2[0], send = hb ? r2[0] : r2[1]; r1 = keep + dppf<0x4E>(0.f, send); }
    r1 += dppf<0xB1>(0.f, r1);
    const auto rr = __builtin_amdgcn_permlane32_swap(__float_as_uint(r1), __float_as_uint(r1), false, false);
    return __uint_as_float(rr[0]) + __uint_as_float(rr[1]);
}
__device__ __forceinline__ unsigned logit_key(float logit, int e) { const unsigned fb = __float_as_uint(logit); const unsigned ord = (fb & 0x80000000u) ? ~fb : (fb | 0x80000000u); return (ord & ~31u) | (unsigned)(31 - e); }
__device__ __forceinline__ void route_row(float la, float lb, int lane, int rowl, LAS int* lcnt, LAS int* sel_e, LAS float* sel_g) {
    const int el = (lane >> 1) & 15;
    unsigned ka = logit_key(la, el), kb = logit_key(lb, 16 + el);
    unsigned tk[4];
#pragma unroll
    for (int k = 0; k < 4; ++k) { tk[k] = wmaxu(max(ka, kb)); ka = (ka == tk[k]) ? 0u : ka; kb = (kb == tk[k]) ? 0u : kb; }
    float tv[4]; int te[4];
#pragma unroll
    for (int k = 0; k < 4; ++k) { te[k] = 31 - (int)(tk[k] & 31u); const unsigned o = tk[k] & ~31u; tv[k] = __uint_as_float((o & 0x80000000u) ? (o & 0x7fffffffu) : ~o); }
    float p[4], s = 0.f;
#pragma unroll
    for (int k = 0; k < 4; ++k) { p[k] = __expf(tv[k] - tv[0]); s += p[k]; }
    const float inv = 1.0f / s;
    if (lane < 4) { const int ek = lane == 0 ? te[0] : lane == 1 ? te[1] : lane == 2 ? te[2] : te[3]; const float gk = (lane == 0 ? p[0] : lane == 1 ? p[1] : lane == 2 ? p[2] : p[3]) * inv;
        const int r = __hip_atomic_fetch_add(lcnt + ek, 1, __ATOMIC_RELAXED, __HIP_MEMORY_SCOPE_WORKGROUP); sel_e[rowl * 4 + lane] = ek | (r << 8); sel_g[rowl * 4 + lane] = gk; }
}
__device__ __forceinline__ void phase_ln_router(TC c_, gptr ws_, const GAS float* lg_, const GAS float* lb_, const GAS float* Wr_, const GAS float* br_, int layer_, int dry_, int fz_, int r0_, int ntl_, int rk_, int nxc_, unsigned* rdy_) {
    TC_UNPACK(); gptr ws = uni(ws_); const int layer = uni(layer_); const int dry = uni(dry_);
    const GAS float* lg = UNIP(const GAS float*, lg_); const GAS float* lb = UNIP(const GAS float*, lb_); const GAS float* Wr = UNIP(const GAS float*, Wr_); const GAS float* br = UNIP(const GAS float*, br_);
    const GAS bf16* XB = (const GAS bf16*)(ws + WS_XB); GAS bf16* XBo = (GAS bf16*)(ws + (dry ? WS_HM : WS_XB)); const GAS bf16* HB = (const GAS bf16*)(ws + WS_HB); GAS v2u* X8 = (GAS v2u*)(ws + (dry ? WS_HM + 64 * MiB : WS_X8));
    GAS unsigned* gcnt = (GAS unsigned*)(ws + WS_CTL) + CW_CNT + layer * 32 + (dry ? 1024 : 0); GAS int* list = (GAS int*)(ws + (dry ? WS_Y : WS_LIST)); GAS float* glist = (GAS float*)(ws + (dry ? WS_Y + 8 * MiB : WS_GLIST));
    LAS int* lcnt = (LAS int*)(lds + MOE_OFF) + 65; LAS int* lbase = lcnt + 32;
    LAS int* sel_e = (LAS int*)(lds + SEL_OFF); LAS float* sel_g = (LAS float*)(lds + SEL_OFF + 2048);
    typedef short bf16x8 __attribute__((ext_vector_type(8)));
    constexpr int XPITCH = 2064, XLO = 16 * XPITCH, PP_OFF = 2 * XLO, PPITCH = 33, PP_ONE = 8 * 16 * PPITCH;
    LAS unsigned char* XS = lds + RING_OFF; LAS float* PP = (LAS float*)(lds + RING_OFF + PP_OFF);
    v4u bh[4][2], bl[4][2];
    { const int n = lane & 15, kq = lane >> 4;
#pragma unroll
      for (int ks = 0; ks < 4; ++ks)
#pragma unroll
          for (int nb = 0; nb < 2; ++nb) { float wv[8];
#pragma unroll
              for (int i = 0; i < 8; ++i) wv[i] = Wr[(size_t)(128 * wave + 32 * ks + 8 * kq + i) * 32 + 16 * nb + n];
              v4u h; h.x = pk2(wv[0], wv[1]); h.y = pk2(wv[2], wv[3]); h.z = pk2(wv[4], wv[5]); h.w = pk2(wv[6], wv[7]);
              v4u l; l.x = pk2(wv[0] - bflo(h.x), wv[1] - bfhi(h.x)); l.y = pk2(wv[2] - bflo(h.y), wv[3] - bfhi(h.y)); l.z = pk2(wv[4] - bflo(h.z), wv[5] - bfhi(h.z)); l.w = pk2(wv[6] - bflo(h.w), wv[7] - bfhi(h.w));
              bh[ks][nb] = h; bl[ks][nb] = l; } }
    const int el = (lane >> 1) & 15;
    LAS float* gb = (LAS float*)(lds + RING_BYTES);
    { const f32x4 t = (tid < 256) ? ((const GAS f32x4*)lg)[tid] : ((const GAS f32x4*)lb)[tid - 256]; *(LAS f32x4*)(gb + 4 * tid) = t; }
    const int fz = uni(fz_), fr0 = uni(r0_), fntl = uni(ntl_), frk = uni(rk_), fnxc = uni(nxc_); unsigned* rdy = (unsigned*)uni((gptr)rdy_);
    const int rb_lo = fz ? 2 * fr0 + frk : (int)blockIdx.x, rb_hi = fz ? 2 * (fr0 + fntl) : T / 128, rb_st = fz ? fnxc : G;
    for (int rb = rb_lo; rb < rb_hi; rb += rb_st) {
        if (fz) { unsigned sp = 0; while (__hip_atomic_load(rdy + (rb >> 1), __ATOMIC_RELAXED, __HIP_MEMORY_SCOPE_AGENT) < 4u) { __builtin_amdgcn_s_sleep(2); if (++sp > (1u << 20)) break; } }
        if (tid < 32) lcnt[tid] = 0;
        __syncthreads();
#pragma unroll 1
        for (int rr = 0; rr < 16; rr += 2) {
            const int rowl = wave * 16 + rr; const size_t row = (size_t)rb * 128 + rowl;
            float v0[16], v1[16];
            v4u hr[2][2];
#pragma unroll
            for (int r2 = 0; r2 < 2; ++r2)
#pragma unroll
                for (int j = 0; j < 2; ++j) { const GAS unsigned long long* hp = (const GAS unsigned long long*)((const GAS v4u*)(HB + (row + r2) * D) + lane + 64 * j);
                    const unsigned long long a0 = __hip_atomic_load(hp, __ATOMIC_RELAXED, __HIP_MEMORY_SCOPE_AGENT), a1 = __hip_atomic_load(hp + 1, __ATOMIC_RELAXED, __HIP_MEMORY_SCOPE_AGENT);
                    hr[r2][j] = (v4u){(unsigned)a0, (unsigned)(a0 >> 32), (unsigned)a1, (unsigned)(a1 >> 32)}; }
#pragma unroll
            for (int j = 0; j < 2; ++j) { float x[8], h[8]; ld_bf8(XB + row * D, lane, j, x); unpack8(hr[0][j], h);
#pragma unroll
                for (int i = 0; i < 8; ++i) v0[8 * j + i] = x[i] * DN_ALPHA + h[i];
                ld_bf8(XB + (row + 1) * D, lane, j, x); unpack8(hr[1][j], h);
#pragma unroll
                for (int i = 0; i < 8; ++i) v1[8 * j + i] = x[i] * DN_ALPHA + h[i]; }
            ln16_lds(v0, gb, lane); ln16_lds(v1, gb, lane);
#pragma unroll
            for (int j = 0; j < 2; ++j) {
                v4u o; o.x = pk2(v0[8 * j], v0[8 * j + 1]); o.y = pk2(v0[8 * j + 2], v0[8 * j + 3]); o.z = pk2(v0[8 * j + 4], v0[8 * j + 5]); o.w = pk2(v0[8 * j + 6], v0[8 * j + 7]);
                ((GAS v4u*)(XBo + row * D))[lane + 64 * j] = o;
                { v4u r; r.x = pk2(v0[8 * j] - bflo(o.x), v0[8 * j + 1] - bfhi(o.x)); r.y = pk2(v0[8 * j + 2] - bflo(o.y), v0[8 * j + 3] - bfhi(o.y)); r.z = pk2(v0[8 * j + 4] - bflo(o.z), v0[8 * j + 5] - bfhi(o.z)); r.w = pk2(v0[8 * j + 6] - bflo(o.w), v0[8 * j + 7] - bfhi(o.w));
                  LAS unsigned char* xp = XS + (2 * wave) * XPITCH + 2 * (8 * lane + 512 * j); *(LAS v4u*)xp = o; *(LAS v4u*)(xp + XLO) = r; }
                v2u q; q.x = pk4f8(v0[8 * j], v0[8 * j + 1], v0[8 * j + 2], v0[8 * j + 3]); q.y = pk4f8(v0[8 * j + 4], v0[8 * j + 5], v0[8 * j + 6], v0[8 * j + 7]); X8[row * (D / 8) + lane + 64 * j] = q;
                o.x = pk2(v1[8 * j], v1[8 * j + 1]); o.y = pk2(v1[8 * j + 2], v1[8 * j + 3]); o.z = pk2(v1[8 * j + 4], v1[8 * j + 5]); o.w = pk2(v1[8 * j + 6], v1[8 * j + 7]);
                ((GAS v4u*)(XBo + (row + 1) * D))[lane + 64 * j] = o;
                { v4u r; r.x = pk2(v1[8 * j] - bflo(o.x), v1[8 * j + 1] - bfhi(o.x)); r.y = pk2(v1[8 * j + 2] - bflo(o.y), v1[8 * j + 3] - bfhi(o.y)); r.z = pk2(v1[8 * j + 4] - bflo(o.z), v1[8 * j + 5] - bfhi(o.z)); r.w = pk2(v1[8 * j + 6] - bflo(o.w), v1[8 * j + 7] - bfhi(o.w));
                  LAS unsigned char* xp = XS + (2 * wave + 1) * XPITCH + 2 * (8 * lane + 512 * j); *(LAS v4u*)xp = o; *(LAS v4u*)(xp + XLO) = r; }
                q.x = pk4f8(v1[8 * j], v1[8 * j + 1], v1[8 * j + 2], v1[8 * j + 3]); q.y = pk4f8(v1[8 * j + 4], v1[8 * j + 5], v1[8 * j + 6], v1[8 * j + 7]); X8[(row + 1) * (D / 8) + lane + 64 * j] = q; }
            __syncthreads();
            LAS float* pp = PP + ((rr >> 1) & 1) * PP_ONE;
            { const int m = lane & 15, kq = lane >> 4;
              f32x4 acc[2] = {(f32x4){0.f, 0.f, 0.f, 0.f}, (f32x4){0.f, 0.f, 0.f, 0.f}};
#pragma unroll
              for (int ks = 0; ks < 4; ++ks) { const LAS unsigned char* ap = XS + m * XPITCH + 2 * (128 * wave + 32 * ks + 8 * kq);
                  const bf16x8 ah = __builtin_bit_cast(bf16x8, *(const LAS v4u*)ap), al = __builtin_bit_cast(bf16x8, *(const LAS v4u*)(ap + XLO));
#pragma unroll
                  for (int nb = 0; nb < 2; ++nb) { const bf16x8 wh = __builtin_bit_cast(bf16x8, bh[ks][nb]), wl = __builtin_bit_cast(bf16x8, bl[ks][nb]);
                      acc[nb] = __builtin_amdgcn_mfma_f32_16x16x32_bf16(ah, wh, acc[nb], 0, 0, 0);
                      acc[nb] = __builtin_amdgcn_mfma_f32_16x16x32_bf16(al, wh, acc[nb], 0, 0, 0);
                      acc[nb] = __builtin_amdgcn_mfma_f32_16x16x32_bf16(ah, wl, acc[nb], 0, 0, 0); } }
#pragma unroll
              for (int nb = 0; nb < 2; ++nb)
#pragma unroll
                  for (int i = 0; i < 4; ++i) pp[(wave * 16 + 4 * kq + i) * PPITCH + 16 * nb + m] = acc[nb][i]; }
            __syncthreads();
#pragma unroll
            for (int r2 = 0; r2 < 2; ++r2) { const int srow = 2 * wave + r2; float la = 0.f, lbv = 0.f;
#pragma unroll
                for (int w8 = 0; w8 < 8; ++w8) { la += pp[(w8 * 16 + srow) * PPITCH + el]; lbv += pp[(w8 * 16 + srow) * PPITCH + 16 + el]; }
                route_row(la + br[el], lbv + br[16 + el], lane, rowl + r2, lcnt, sel_e, sel_g); }
        }
        __syncthreads();
        if (tid < 32) lbase[tid] = (int)__hip_atomic_fetch_add(gcnt + tid, (unsigned)lcnt[tid], __ATOMIC_RELAXED, __HIP_MEMORY_SCOPE_AGENT);
        __syncthreads();
        { const int se = sel_e[tid]; const int e = se & 255, r = se >> 8; const int a = (rb * 128 + (tid >> 2)) * 4 + (tid & 3);
          list[(size_t)e * T + lbase[e] + r] = a; glist[(size_t)e * T + lbase[e] + r] = sel_g[tid]; }
        __syncthreads();
    }
}
__device__ __noinline__ void phase_combine(TC c_, gptr ws_, const GAS float* lg_, const GAS float* lb_, GAS float* out_, int w8_) {
    TC_UNPACK(); gptr ws = uni(ws_); const int w8 = uni(w8_); GAS v2u* X8 = (GAS v2u*)(ws + WS_X8); const GAS float* lg = UNIP(const GAS float*, lg_); const GAS float* lb = UNIP(const GAS float*, lb_); GAS float* out = UNIP(GAS float*, out_);
    GAS bf16* XB = (GAS bf16*)(ws + WS_XB); const GAS unsigned char* Y = (const GAS unsigned char*)(ws + WS_Y);
    LAS float* gb = (LAS float*)(lds + RING_BYTES);
    { const f32x4 t = (tid < 256) ? ((const GAS f32x4*)lg)[tid] : ((const GAS f32x4*)lb)[tid - 256]; *(LAS f32x4*)(gb + 4 * tid) = t; }
    __syncthreads();
    v4u cx[2], nx[2]; v2u cy[4][2], ny[4][2];
    int row = gw;
    if (row < T) {
#pragma unroll
        for (int j = 0; j < 2; ++j) { cx[j] = ((const GAS v4u*)(XB + (size_t)row * D))[lane + 64 * j];
#pragma unroll
            for (int k = 0; k < 4; ++k) cy[k][j] = ((const GAS v2u*)(Y + ((size_t)row * 4 + k) * D))[lane + 64 * j]; } }
#pragma unroll 1
    for (; row < T; row += NGW) {
        const int nrow = row + NGW;
        if (nrow < T) {
#pragma unroll
            for (int j = 0; j < 2; ++j) { nx[j] = ((const GAS v4u*)(XB + (size_t)nrow * D))[lane + 64 * j];
#pragma unroll
                for (int k = 0; k < 4; ++k) ny[k][j] = ((const GAS v2u*)(Y + ((size_t)nrow * 4 + k) * D))[lane + 64 * j]; } }
        float v[16];
#pragma unroll
        for (int j = 0; j < 2; ++j) { float x[8]; unpack8(cx[j], x);
#pragma unroll
            for (int i = 0; i < 8; ++i) v[8 * j + i] = x[i] * DN_ALPHA;
#pragma unroll
            for (int k = 0; k < 4; ++k) { const f32x2v a0 = __builtin_amdgcn_cvt_pk_f32_fp8((int)cy[k][j].x, false), a1 = __builtin_amdgcn_cvt_pk_f32_fp8((int)cy[k][j].x, true), a2 = __builtin_amdgcn_cvt_pk_f32_fp8((int)cy[k][j].y, false), a3 = __builtin_amdgcn_cvt_pk_f32_fp8((int)cy[k][j].y, true);
                v[8 * j] += a0.x * 0.015625f; v[8 * j + 1] += a0.y * 0.015625f; v[8 * j + 2] += a1.x * 0.015625f; v[8 * j + 3] += a1.y * 0.015625f; v[8 * j + 4] += a2.x * 0.015625f; v[8 * j + 5] += a2.y * 0.015625f; v[8 * j + 6] += a3.x * 0.015625f; v[8 * j + 7] += a3.y * 0.015625f; } }
        ln16_lds(v, gb, lane);
        if (out) {
#pragma unroll
            for (int j = 0; j < 2; ++j) { ((GAS f32x4*)(out + (size_t)row * D))[2 * lane + 128 * j] = (f32x4){v[8 * j], v[8 * j + 1], v[8 * j + 2], v[8 * j + 3]};
                ((GAS f32x4*)(out + (size_t)row * D))[2 * lane + 128 * j + 1] = (f32x4){v[8 * j + 4], v[8 * j + 5], v[8 * j + 6], v[8 * j + 7]}; }
        } else {
#pragma unroll
            for (int j = 0; j < 2; ++j) { v4u o; o.x = pk2(v[8 * j], v[8 * j + 1]); o.y = pk2(v[8 * j + 2], v[8 * j + 3]); o.z = pk2(v[8 * j + 4], v[8 * j + 5]); o.w = pk2(v[8 * j + 6], v[8 * j + 7]);
                ((GAS v4u*)(XB + (size_t)row * D))[lane + 64 * j] = o;
                if (w8) { v2u q; q.x = pk4f8(v[8 * j], v[8 * j + 1], v[8 * j + 2], v[8 * j + 3]); q.y = pk4f8(v[8 * j + 4], v[8 * j + 5], v[8 * j + 6], v[8 * j + 7]); X8[(size_t)row * (D / 8) + lane + 64 * j] = q; } }
        }
#pragma unroll
        for (int j = 0; j < 2; ++j) { cx[j] = nx[j];
#pragma unroll
            for (int k = 0; k < 4; ++k) cy[k][j] = ny[k][j]; }
    }
}
__device__ __forceinline__ void rope_piece(GAS bf16* p, const GAS float* g8, const GAS f32x2v* cs4, float scale) {
    v4u w = *(GAS v4u*)p; float x[8] = {bflo(w.x), bfhi(w.x), bflo(w.y), bfhi(w.y), bflo(w.z), bfhi(w.z), bflo(w.w), bfhi(w.w)};
    float ss = 0.f;
#pragma unroll
    for (int i = 0; i < 8; ++i) ss += x[i] * x[i];
    ss += __shfl_xor(ss, 1); ss += __shfl_xor(ss, 2); ss += __shfl_xor(ss, 4);
    const float r = 1.0f / sqrtf(ss * (1.0f / 64.0f) + QK_EPS) ;
    const f32x4 g0 = ((const GAS f32x4*)g8)[0], g1 = ((const GAS f32x4*)g8)[1];
    const float gg[8] = {g0.x, g0.y, g0.z, g0.w, g1.x, g1.y, g1.z, g1.w};
    float y[8];
#pragma unroll
    for (int i = 0; i < 8; ++i) x[i] = x[i] * r * gg[i];
#pragma unroll
    for (int i = 0; i < 4; ++i) { const f32x2v cs = cs4[i]; y[2 * i] = (x[2 * i] * cs.x - x[2 * i + 1] * cs.y) * scale; y[2 * i + 1] = (x[2 * i] * cs.y + x[2 * i + 1] * cs.x) * scale; }
    w.x = pk2(y[0], y[1]); w.y = pk2(y[2], y[3]); w.z = pk2(y[4], y[5]); w.w = pk2(y[6], y[7]);
    *(GAS v4u*)p = w;
}
__device__ __noinline__ void phase_qk_rope(TC c_, gptr ws_, const GAS float* qg_, const GAS float* kg_) {
    TC_UNPACK(); gptr ws = uni(ws_); const GAS float* qg = UNIP(const GAS float*, qg_); const GAS float* kg = UNIP(const GAS float*, kg_);
    GAS bf16* Q = (GAS bf16*)(ws + WS_MIX); GAS bf16* Kb = (GAS bf16*)(ws + WS_MIX + 64 * MiB); const GAS f32x2v* rope = (const GAS f32x2v*)(ws + WS_ROPE);
    const int sub = lane & 7;
    for (int row = gw; row < T; row += NGW) {
        const GAS f32x2v* cs = rope + (size_t)(row & (SEQ - 1)) * 32 + sub * 4;
        rope_piece(Q + (size_t)row * D + lane * 8, qg + sub * 8, cs, attn_body::C2);
        rope_piece(Q + (size_t)row * D + 512 + lane * 8, qg + sub * 8, cs, attn_body::C2);
        if (lane < 32) rope_piece(Kb + (size_t)row * 256 + lane * 8, kg + sub * 8, cs, 1.0f);
    }
}
__device__ __noinline__ void phase_vstats(TC c_, gptr ws_) {
    TC_UNPACK(); gptr ws = uni(ws_); const GAS bf16* Z = (const GAS bf16*)(ws + WS_MIX); GAS f32x2v* stats = (GAS f32x2v*)(ws + WS_STATS);
    for (int row = gw; row < T; row += NGW) {
        const GAS v4u* p = (const GAS v4u*)(Z + (size_t)row * 4096 + 2048);
        float x[32]; float s = 0.f;
#pragma unroll
        for (int j = 0; j < 4; ++j) { const v4u w = p[lane + 64 * j]; x[8 * j] = bflo(w.x); x[8 * j + 1] = bfhi(w.x); x[8 * j + 2] = bflo(w.y); x[8 * j + 3] = bfhi(w.y); x[8 * j + 4] = bflo(w.z); x[8 * j + 5] = bfhi(w.z); x[8 * j + 6] = bflo(w.w); x[8 * j + 7] = bfhi(w.w); }
#pragma unroll
        for (int i = 0; i < 32; ++i) s += x[i];
        const float mean = wave_sum(s) * (1.0f / 2048.0f); float s2 = 0.f;
#pragma unroll
        for (int i = 0; i < 32; ++i) { const float d = x[i] - mean; s2 += d * d; }
        const float rstd = 1.0f / sqrtf(wave_sum(s2) * (1.0f / 2048.0f) + LN_EPS);
        if (lane == 0) stats[row] = (f32x2v){mean, rstd};
    }
}
__device__ __forceinline__ void phase_spatial(TC c_, gptr ws_, const GAS float* ng_, const GAS float* nb_, const GAS float* bs_) {
    TC_UNPACK(); gptr ws = uni(ws_); const GAS float* ng = UNIP(const GAS float*, ng_); const GAS float* nb = UNIP(const GAS float*, nb_); const GAS float* bs = UNIP(const GAS float*, bs_);
    const GAS bf16* Z = (const GAS bf16*)(ws + WS_MIX); const GAS f32x2v* stats = (const GAS f32x2v*)(ws + WS_STATS); const GAS bf16* Wsb = (const GAS bf16*)(ws + WS_WS); GAS unsigned char* GU = (GAS unsigned char*)(ws + WS_MIX + 256 * MiB);
    typedef short bf16x8 __attribute__((ext_vector_type(8)));
    constexpr int PITCH = 136, VP = 132;
    LAS bf16* WsL = (LAS bf16*)(lds + RING_OFF);
    LAS bf16* VtL = WsL + 128 * PITCH;
    LAS unsigned* Vt32 = (LAS unsigned*)VtL;
    const int fr = lane & 15, fq = lane >> 4, pr = wave >> 2, dc = wave & 3;
    const int ql = (tid & 7) + 8 * (tid >> 8), dch = (tid >> 3) & 31, d0 = dch * 8; const bool odd = tid & 1;
    v4u wv[8]; f32x2v st[8];
    int u = blockIdx.x;
    if (u < 2048) { const int c = u >> 3, g = u & 7;
#pragma unroll
        for (int it = 0; it < 8; ++it) { const size_t t = (size_t)c * 128 + 16 * it + ql; wv[it] = *(const GAS v4u*)(Z + t * 4096 + 2048 + g * 256 + d0); st[it] = stats[t]; } }
#pragma unroll 1
    for (; u < 2048; u += G) {
        const int c = u >> 3, g = u & 7;
        const f32x4 g0 = *(const GAS f32x4*)(ng + g * 256 + d0), g1 = *(const GAS f32x4*)(ng + g * 256 + d0 + 4), b0 = *(const GAS f32x4*)(nb + g * 256 + d0), b1 = *(const GAS f32x4*)(nb + g * 256 + d0 + 4);
        const float gg[8] = {g0.x, g0.y, g0.z, g0.w, g1.x, g1.y, g1.z, g1.w}, bb[8] = {b0.x, b0.y, b0.z, b0.w, b1.x, b1.y, b1.z, b1.w};
#pragma unroll
        for (int it = 0; it < 4; ++it) { const int id = it * 512 + tid, p = id >> 4, ch = id & 15; const v4u w = *(const GAS v4u*)(Wsb + (size_t)g * 16384 + p * 128 + ch * 8); *(LAS v4u*)(WsL + p * PITCH + ch * 8) = w; }
#pragma unroll
        for (int it = 0; it < 8; ++it) { float x[8]; unpack8(wv[it], x); unsigned y[8];
#pragma unroll
            for (int i = 0; i < 8; ++i) y[i] = f2bf((x[i] - st[it].x) * st[it].y * gg[i] + bb[i]);
            const int qh = (16 * it + ql) >> 1;
#pragma unroll
            for (int j = 0; j < 4; ++j) { const unsigned mine = odd ? y[4 + j] : y[j], send = odd ? y[j] : y[4 + j];
                const unsigned got = dppu<0xB1>(0u, send);
                const int dd = d0 + (odd ? 4 : 0) + j, rho = (dd & ~63) + 16 * ((dd >> 2) & 3) + 4 * ((dd >> 4) & 3) + (dd & 3);
                Vt32[rho * (VP / 2) + qh] = odd ? (got | (mine << 16)) : (mine | (got << 16)); } }
        __syncthreads();
        v4u uu[4][2];
#pragma unroll
        for (int m = 0; m < 4; ++m) { const size_t t = (size_t)c * 128 + 64 * pr + 16 * m + fr; const GAS v4u* up = (const GAS v4u*)(Z + t * 4096 + g * 256 + 64 * dc + 16 * fq); uu[m][0] = up[0]; uu[m][1] = up[1]; }
        { const int un = u + G; if (un < 2048) { const int cn = un >> 3, gn = un & 7;
#pragma unroll
            for (int it = 0; it < 8; ++it) { const size_t t = (size_t)cn * 128 + 16 * it + ql; wv[it] = *(const GAS v4u*)(Z + t * 4096 + 2048 + gn * 256 + d0); st[it] = stats[t]; } } }
        f32x4 acc[4][4];
#pragma unroll
        for (int m = 0; m < 4; ++m)
#pragma unroll
            for (int n = 0; n < 4; ++n) acc[m][n] = (f32x4){0.f, 0.f, 0.f, 0.f};
#pragma unroll 1
        for (int k = 0; k < 4; ++k) {
            bf16x8 af[4], bfr[4];
#pragma unroll
            for (int m = 0; m < 4; ++m) af[m] = *(const LAS bf16x8*)(WsL + (64 * pr + 16 * m + fr) * PITCH + 32 * k + 8 * fq);
#pragma unroll
            for (int n = 0; n < 4; ++n) { const LAS v2u* p = (const LAS v2u*)(VtL + (64 * dc + 16 * n + fr) * VP + 32 * k + 8 * fq); const v2u lo = p[0], hi = p[1]; bfr[n] = __builtin_bit_cast(bf16x8, (v4u){lo.x, lo.y, hi.x, hi.y}); }
#pragma unroll
            for (int m = 0; m < 4; ++m)
#pragma unroll
                for (int n = 0; n < 4; ++n) acc[m][n] = __builtin_amdgcn_mfma_f32_16x16x32_bf16(bfr[n], af[m], acc[m][n], 0, 0, 0);
        }
#pragma unroll
        for (int m = 0; m < 4; ++m) { const int p = 64 * pr + 16 * m + fr; const float bsp = bs[g * 128 + p]; const size_t t = (size_t)c * 128 + p;
            float uf[16]; { float x8[8]; unpack8(uu[m][0], x8);
#pragma unroll
                for (int i = 0; i < 8; ++i) uf[i] = x8[i];
                unpack8(uu[m][1], x8);
#pragma unroll
                for (int i = 0; i < 8; ++i) uf[8 + i] = x8[i]; }
            v4u w;
#pragma unroll
            for (int n = 0; n < 4; ++n) { const f32x4 r = (acc[m][n] + bsp) * (f32x4){uf[4 * n], uf[4 * n + 1], uf[4 * n + 2], uf[4 * n + 3]}; w[n] = pk4f8(r.x, r.y, r.z, r.w); }
            *(GAS v4u*)(GU + t * 2048 + g * 256 + 64 * dc + 16 * fq) = w; }
        __syncthreads();
    }
}
__device__ __forceinline__ void conv_row(const GAS bf16* Hc, const GAS float* cw, GAS unsigned char* Gc, int row, int lane) {
    const int s = row & (SEQ - 1);
#pragma unroll
    for (int jj = 0; jj < 2; ++jj) { const int ch = (lane + 64 * jj) * 8;
        float acc[8];
#pragma unroll
        for (int i = 0; i < 8; ++i) acc[i] = 0.f;
#pragma unroll
        for (int k = 0; k < 3; ++k) { const int sk = s + k - 1; if (sk < 0 || sk >= SEQ) continue; const size_t r2 = (size_t)(row + k - 1) * 3072;
            float cc[8], xv[8]; unpack8(*(const GAS v4u*)(Hc + r2 + 1024 + ch), cc); unpack8(*(const GAS v4u*)(Hc + r2 + 2048 + ch), xv);
            const f32x4 w0 = *(const GAS f32x4*)(cw + k * 1024 + ch), w1 = *(const GAS f32x4*)(cw + k * 1024 + ch + 4); const float ww[8] = {w0.x, w0.y, w0.z, w0.w, w1.x, w1.y, w1.z, w1.w};
#pragma unroll
            for (int i = 0; i < 8; ++i) acc[i] += cc[i] * xv[i] * ww[i]; }
        float bg[8]; unpack8(*(const GAS v4u*)(Hc + (size_t)row * 3072 + ch), bg);
        v2u o; o.x = pk4f8(bg[0] * acc[0], bg[1] * acc[1], bg[2] * acc[2], bg[3] * acc[3]); o.y = pk4f8(bg[4] * acc[4], bg[5] * acc[5], bg[6] * acc[6], bg[7] * acc[7]);
        *(GAS v2u*)(Gc + (size_t)row * 1024 + ch) = o; }
}
__device__ __noinline__ void phase_conv(TC c_, gptr ws_, const GAS float* cw_) {
    TC_UNPACK(); gptr ws = uni(ws_); const GAS float* cw = UNIP(const GAS float*, cw_);
    const GAS bf16* Hc = (const GAS bf16*)(ws + WS_MIX); GAS unsigned char* Gc = (GAS unsigned char*)(ws + WS_MIX + 192 * MiB);
    for (int row = gw; row < T; row += 2 * NGW) { conv_row(Hc, cw, Gc, row, lane); if (row + NGW < T) conv_row(Hc, cw, Gc, row + NGW, lane); }
}
__device__ __noinline__ void moe_table(TC c_, gptr ws_, int layer_) {
    TC_UNPACK(); gptr ws = uni(ws_); const int layer = uni(layer_);
    GAS unsigned* gcnt = (GAS unsigned*)(ws + WS_CTL) + CW_CNT + layer * 32;
    LAS int* tstart = (LAS int*)(lds + MOE_OFF); LAS int* cntl = tstart + 33;
    if (tid < 32) { int cv = (int)__hip_atomic_load(gcnt + tid, __ATOMIC_RELAXED, __HIP_MEMORY_SCOPE_AGENT); cv = cv < 0 ? 0 : (cv > T ? T : cv); cntl[tid] = cv; }
    __syncthreads();
    if (tid == 0) { int s = 0; for (int e = 0; e < 32; ++e) { tstart[e] = s; s += (cntl[e] + 255) >> 8; } tstart[32] = s; }
    __syncthreads();
}

constexpr int NPH = 1 + 8 * NLAYER;
struct Args { const float* in[24]; float* out; unsigned char* ws; int ph_lo, ph_hi; };
__global__ void __launch_bounds__(512, 2) fwd(Args args) {
    extern __shared__ __attribute__((aligned(16))) unsigned char lds_raw[];
    const int wave_id = __builtin_amdgcn_readfirstlane((int)threadIdx.x >> 6);
    { const int tid0 = threadIdx.x; for (int u = tid0; u < (LDS_BYTES - LDSCTL_OFF) / 4; u += 512) ((LAS unsigned*)((LAS unsigned char*)lds_raw + LDSCTL_OFF))[u] = 0u; }
    __syncthreads();
    const int lo = args.ph_lo, hi = args.ph_hi;
    const bool use_bar = (hi - lo) > 1;
    XcdBarrier bar; bar.bar = (unsigned*)(args.ws + WS_CTL) + CW_BAR; bar.x = 0; bar.st = nullptr; bar.wave = wave_id;
    if (use_bar) bar = xcd_barrier_post((unsigned*)(args.ws + WS_CTL) + CW_BAR, (volatile LAS unsigned*)((LAS unsigned char*)lds_raw + MISC_OFF) + 8);
    bar.wave = wave_id;
#ifndef DUP_MASK
#define DUP_MASK 0
#endif
#define DUPL(b) _Pragma("unroll 1") for (int rep_ = 0; rep_ <= ((DUP_MASK >> (b)) & 1); ++rep_)
#define IN(k) (lo <= (k) && (k) < hi)
#define FUSED_DENSE() const volatile LAS unsigned* fd_ = (const volatile LAS unsigned*)((LAS unsigned char*)lds_raw + MISC_OFF) + 8; \
    const int fnx = __builtin_amdgcn_readfirstlane((int)fd_[0]), frk = __builtin_amdgcn_readfirstlane((int)fd_[2]), fpre = __builtin_amdgcn_readfirstlane((int)fd_[3]); \
    const int dr0 = (int)((128L * fpre) / G_), dnt = (int)((128L * (fpre + fnx)) / G_) - dr0; \
    unsigned* rdy2 = (unsigned*)(ws + WS_CTL) + CW_RDY2 + layer * 128
#define FUSED_SETUP() const volatile LAS unsigned* fm_ = (const volatile LAS unsigned*)((LAS unsigned char*)lds_raw + MISC_OFF) + 8; \
    const int fnx = __builtin_amdgcn_readfirstlane((int)fm_[0]), frk = __builtin_amdgcn_readfirstlane((int)fm_[2]), fpre = __builtin_amdgcn_readfirstlane((int)fm_[3]); \
    const int fr0 = (int)(((long)TM * fpre) / G_), fnt = (int)(((long)TM * (fpre + fnx)) / G_) - fr0; \
    unsigned* rdy = (unsigned*)(ws + WS_CTL) + CW_RDY + layer * 640
#ifndef DUP_BAR
#define DUP_BAR 0
#endif
#define SEAM(k) do { if (IN((k) + 1)) { _Pragma("unroll 1") for (int rb_ = 0; rb_ <= DUP_BAR; ++rb_) { XcdBarrier b2_ = bar; size_t zb_; asm volatile("s_mov_b64 %0, 0" : "=s"(zb_)); b2_.bar = bar.bar + zb_; xcd_barrier(b2_); } } } while (0)
#define ENTER() size_t zq; asm volatile("s_mov_b64 %0, 0" : "=s"(zq)); unsigned char* ws = args.ws + zq; const gptr wsg = (gptr)ws; (void)wsg; const TC tc = mk_tc(wave_id); const int tid = wave_id * 64 + tc.lane; (void)tid; \
    LAS unsigned char* ring = (LAS unsigned char*)lds_raw + RING_OFF; (void)ring; const int G_ = gridDim.x; (void)G_
#define GIN(k) ((const GAS float*)(args.in[k] + zq))

    if (IN(0)) { ENTER(); DUPL(0) { p0_dense(tc, wsg, GIN(1), GIN(4), GIN(5), GIN(10), GIN(11), GIN(13)); p0_misc(tc, wsg, GIN(0), GIN(8), GIN(21)); } SEAM(0); }

#pragma unroll 1
    for (int layer = 0; layer < NLAYER; ++layer) {
        const int kind = layer % 3, j = layer / 3, pb = 1 + 8 * layer;
        if (kind == 0) {
            if (IN(pb + 0)) {
                ENTER(); bf16* Q = (bf16*)(ws + WS_MIX); bf16* Kb = (bf16*)(ws + WS_MIX + 64 * MiB); bf16* Vb = (bf16*)(ws + WS_MIX + 80 * MiB);
                pg8::DenseSched S{ws + WS_X8, ws + WS_WQKV + (size_t)j * 1536 * 1024, 1024, 1024, T / 256, 6, G_, (int)blockIdx.x, 0, 0, 0, 0, 0, nullptr};
                pg8::EpiBf16<0, 1> E{Q, 1024, Kb, Vb};
                pg8::gemm_phase<true>(ring, 1024, S, E, tid, WGU_E8M0); if constexpr ((DUP_MASK >> 1) & 1) { pg8::gemm_phase<true>(ring, 1024, S, E, tid, WGU_E8M0); }
                SEAM(pb + 0);
            }
            if (IN(pb + 1)) { ENTER(); phase_qk_rope(tc, wsg, GIN(2) + j * 64, GIN(3) + j * 64); SEAM(pb + 1); }
            if (IN(pb + 2)) {
                ENTER(); bf16* Q = (bf16*)(ws + WS_MIX); bf16* Kb = (bf16*)(ws + WS_MIX + 64 * MiB); bf16* Vb = (bf16*)(ws + WS_MIX + 80 * MiB);
                const attn_body::AttnTensors AT{(const attn_body::bf16*)Q, (const attn_body::bf16*)Kb, (const attn_body::bf16*)Vb, (attn_body::bf16*)(ws + WS_MIX + 128 * MiB)};
                const attn_body::GqaOrder S(G_, (int)blockIdx.x);
                float m0; { float aq = fabsf((GIN(2) + j * 64)[tc.lane]), ak = fabsf((GIN(3) + j * 64)[tc.lane]);
                    aq = __uint_as_float(wmaxu(__float_as_uint(aq))); ak = __uint_as_float(wmaxu(__float_as_uint(ak)));
                    m0 = attn_body::C2 * 64.0f * 1.03f * aq * ak + 0.25f; }
                (void)S;
                unsigned* qctr = (unsigned*)(ws + WS_CTL) + CW_QUE + (layer ? 256 : 0);
                attn_body::attn_phase_dyn<8>((char*)lds_raw + RING_OFF, AT, tid, m0, qctr, (volatile LAS unsigned*)((LAS unsigned char*)lds_raw + MISC_OFF) + 12, (int)(xb_xcc_id() & 7u), layer == 0 ? 192 : 0,
                    [&](int chunk) { p0_chunk(tc, wsg, GIN(20), GIN(22), chunk); });
                SEAM(pb + 2);
            }
            if (IN(pb + 3)) {
                ENTER();
                FUSED_DENSE();
                pg8::DenseSched S{ws + WS_MIX + 128 * MiB, ws + WS_WO + (size_t)j * 1024 * 1024, 1024, 1024, T / 256, 4, G_, (int)blockIdx.x, FUSE_PL, dr0, dnt, frk, fnx, rdy2};
                pg8::EpiBf16<0, 0> E{(bf16*)(ws + WS_HB), 1024, nullptr, nullptr};
                pg8::gemm_phase<true>(ring, 1024, S, E, tid, WDN_E8M0, WGU_E8M0); if constexpr ((DUP_MASK >> 4) & 1) { pg8::gemm_phase<true>(ring, 1024, S, E, tid, WDN_E8M0, WGU_E8M0); }
                if (!FUSE_PL) SEAM(pb + 3);
            }
        } else if (kind == 1) {
            if (IN(pb + 0)) {
                ENTER();
                pg8::DenseSched S{ws + WS_X8, ws + WS_GIN, 1024, 1024, T / 256, 16, G_, (int)blockIdx.x, 0, 0, 0, 0, 0, nullptr};
                pg8::EpiBf16<1, 0> E{(bf16*)(ws + WS_MIX), 4096, nullptr, nullptr};
                pg8::gemm_phase<true>(ring, 1024, S, E, tid, WGU_E8M0); if constexpr ((DUP_MASK >> 5) & 1) { pg8::gemm_phase<true>(ring, 1024, S, E, tid, WGU_E8M0); }
                SEAM(pb + 0);
            }
            if (IN(pb + 1)) { ENTER(); DUPL(6) phase_vstats(tc, wsg); SEAM(pb + 1); }
            if (IN(pb + 2)) { ENTER(); DUPL(7) phase_spatial(tc, wsg, GIN(6), GIN(7), GIN(9)); SEAM(pb + 2); }
            if (IN(pb + 3)) {
                ENTER();
                FUSED_DENSE();
                pg8::DenseSched S{ws + WS_MIX + 256 * MiB, ws + WS_GOUT, 2048, 2048, T / 256, 4, G_, (int)blockIdx.x, FUSE_PL, dr0, dnt, frk, fnx, rdy2};
                pg8::EpiBf16<0, 0> E{(bf16*)(ws + WS_HB), 1024, nullptr, nullptr};
                pg8::gemm_phase<true>(ring, 2048, S, E, tid, WDN_E8M0); if constexpr ((DUP_MASK >> 8) & 1) { pg8::gemm_phase<true>(ring, 2048, S, E, tid, WDN_E8M0); }
                if (!FUSE_PL) SEAM(pb + 3);
            }
        } else {
            if (IN(pb + 0)) {
                ENTER();
                pg8::DenseSched S{ws + WS_XB, ws + WS_CIN, 2048, 2048, T / 256, 12, G_, (int)blockIdx.x, 0, 0, 0, 0, 0, nullptr};
                pg8::EpiBf16<0, 0> E{(bf16*)(ws + WS_MIX), 3072, nullptr, nullptr};
                pg8::gemm_phase<false>(ring, 2048, S, E, tid); if constexpr ((DUP_MASK >> 9) & 1) { pg8::gemm_phase<false>(ring, 2048, S, E, tid); }
                SEAM(pb + 0);
            }
            if (IN(pb + 1)) { ENTER(); DUPL(10) phase_conv(tc, wsg, GIN(12)); SEAM(pb + 1); }
            if (IN(pb + 3)) {
                ENTER();
                FUSED_DENSE();
                pg8::DenseSched S{ws + WS_MIX + 192 * MiB, ws + WS_COUT, 1024, 1024, T / 256, 4, G_, (int)blockIdx.x, FUSE_PL, dr0, dnt, frk, fnx, rdy2};
                pg8::EpiBf16<0, 0> E{(bf16*)(ws + WS_HB), 1024, nullptr, nullptr};
                pg8::gemm_phase<true>(ring, 1024, S, E, tid, WDN_E8M0); if constexpr ((DUP_MASK >> 11) & 1) { pg8::gemm_phase<true>(ring, 1024, S, E, tid, WDN_E8M0); }
                if (!FUSE_PL) SEAM(pb + 3);
            }
        }
        if (IN(pb + 4)) {
            ENTER(); if constexpr ((DUP_MASK >> 12) & 1) { FUSED_DENSE(); phase_ln_router(tc, wsg, GIN(14) + layer * D, GIN(15) + layer * D, GIN(18) + (size_t)layer * D * NE, GIN(19) + layer * NE, layer, 1, FUSE_PL, dr0, dnt, frk, fnx, rdy2); __syncthreads(); }
            { FUSED_DENSE(); phase_ln_router(tc, wsg, GIN(14) + layer * D, GIN(15) + layer * D, GIN(18) + (size_t)layer * D * NE, GIN(19) + layer * NE, layer, 0, FUSE_PL, dr0, dnt, frk, fnx, rdy2); }
            SEAM(pb + 4);
        }
        if (IN(pb + 5) || IN(pb + 6)) { ENTER(); moe_table(tc, wsg, layer); }
        if (IN(pb + 5)) {
            ENTER(); LAS int* tstart = (LAS int*)((LAS unsigned char*)lds_raw + MOE_OFF); LAS int* cntl = tstart + 33; const int TM = __builtin_amdgcn_readfirstlane(tstart[32]);
            FUSED_SETUP();
            pg8::GroupedSched<true> S{ws + WS_X8, ws + WS_WGU + (size_t)layer * 32 * 2048 * 1024, (const int*)(ws + WS_LIST), (const float*)(ws + WS_GLIST), tstart, cntl, 1024, 2048, 8, TM, G_, (int)blockIdx.x,
                                      FUSE_GD, fr0, fnt, frk, fnx, 0, rdy};
            pg8::EpiSwiglu8 E{ws + WS_HM, (const float*)(ws + WS_BGU) + (size_t)layer * 32 * 2048};
            DUPL(13) pg8::gemm_phase<true>(ring, 1024, S, E, tid, WGU_E8M0);
            if (!FUSE_GD) SEAM(pb + 5);
        }
        if (IN(pb + 6)) {
            ENTER(); LAS int* tstart = (LAS int*)((LAS unsigned char*)lds_raw + MOE_OFF); LAS int* cntl = tstart + 33; const int TM = __builtin_amdgcn_readfirstlane(tstart[32]);
            FUSED_SETUP();
            const int fNg = fnt * 8, fi0 = (fNg > frk) ? (fNg - frk + fnx - 1) / fnx : 0;
            pg8::GroupedSched<false> S{ws + WS_HM, ws + WS_WDN + (size_t)layer * 32 * 1024 * 1024, (const int*)(ws + WS_LIST), (const float*)(ws + WS_GLIST), tstart, cntl, 1024, 1024, 4, TM, G_, (int)blockIdx.x,
                                       FUSE_GD, fr0, fnt, frk, fnx, fi0 * fnx - fNg, rdy};
            pg8::EpiDown E{ws + WS_Y, args.in[23] + zq + (size_t)layer * 32 * 1024, ring};
            DUPL(14) pg8::gemm_phase<true>(ring, 1024, S, E, tid, WDN_E8M0);
            SEAM(pb + 6);
        }
        if (IN(pb + 7)) {
            ENTER(); const bool fin = (layer == NLAYER - 1);
            _Pragma("unroll 1") for (int rep_ = 0; rep_ <= ((fin && ((DUP_MASK >> 15) & 1)) ? 1 : 0); ++rep_)
            phase_combine(tc, wsg, GIN(16) + layer * D, GIN(17) + layer * D, fin ? (GAS float*)(args.out + zq) : (GAS float*)nullptr, 1);
            SEAM(pb + 7);
        }
    }
#undef IN
#undef SEAM
#undef ENTER
}

#ifndef MK_PER_PHASE
#define MK_PER_PHASE 0
#endif
extern "C" void kernel_launch(void* const* d_in, const int* in_sizes, int n_in, void* d_out, int out_size, void* d_ws, size_t ws_size, hipStream_t stream) {
    static int grid = 0;
    if (grid == 0) {
        if (n_in != 24 || in_sizes[0] != T * D || out_size != T * D || ws_size < WS_END) { fprintf(stderr, "kernel_launch: unexpected shapes (n_in %d, in0 %d, out %d, ws %zu); nothing launched\n", n_in, n_in > 0 ? in_sizes[0] : -1, out_size, ws_size); grid = -1; return; }
        int dev = 0, cus = 0, per_cu = 0;
        if (hipGetDevice(&dev) != hipSuccess || hipDeviceGetAttribute(&cus, hipDeviceAttributeMultiprocessorCount, dev) != hipSuccess) { grid = -1; return; }
        if (hipFuncSetAttribute((const void*)fwd, hipFuncAttributeMaxDynamicSharedMemorySize, LDS_BYTES) != hipSuccess) { fprintf(stderr, "kernel_launch: hipFuncSetAttribute failed\n"); grid = -1; return; }
        if (hipOccupancyMaxActiveBlocksPerMultiprocessor(&per_cu, (const void*)fwd, 512, LDS_BYTES) != hipSuccess || per_cu < 1) { fprintf(stderr, "kernel_launch: occupancy query says %d\n", per_cu); }
        (void)hipGetLastError();
        grid = cus;
    }
    if (grid < 0) return;
    if (hipMemsetAsync((char*)d_ws + WS_CTL, 0, CTL_ZERO_BYTES, stream) != hipSuccess) return;
    Args a{};
    for (int i = 0; i < 24; ++i) a.in[i] = (const float*)d_in[i];
    a.out = (float*)d_out; a.ws = (unsigned char*)d_ws;
#if MK_PER_PHASE
    for (int p = 0; p < NPH; ++p) { a.ph_lo = p; a.ph_hi = p + 1; hipLaunchKernelGGL(fwd, dim3(grid), dim3(512), LDS_BYTES, stream, a); }
#else
    a.ph_lo = 0; a.ph_hi = NPH;
    hipLaunchKernelGGL(fwd, dim3(grid), dim3(512), LDS_BYTES, stream, a);
#endif
    const hipError_t le = hipPeekAtLastError();
    if (le != hipSuccess) fprintf(stderr, "kernel_launch: launch failed: %s\n", hipGetErrorName(le));
}
```

```cpp
#include <hip/hip_runtime.h>
#include <hip/hip_bf16.h>
#include <cstdio>
#include <cstdint>
#include <cmath>
namespace pg8 {
#define PG8_LAS __attribute__((address_space(3)))
typedef unsigned short bf16_t;
typedef short bf16x8 __attribute__((ext_vector_type(8)));
typedef float f32x4 __attribute__((ext_vector_type(4)));
typedef float f32x2 __attribute__((ext_vector_type(2)));
typedef unsigned u32x4 __attribute__((ext_vector_type(4)));
typedef unsigned u32x2 __attribute__((ext_vector_type(2)));
typedef int v4i32_t __attribute__((ext_vector_type(4)));
typedef int v8i32_t __attribute__((ext_vector_type(8)));
constexpr int BM = 256, BK = 64, HALF = 128, HTB = HALF * BK * 2  , STAGE_BYTES = 8 * HTB, NXCD = 8, WGM = 8;

__host__ __device__ __forceinline__ int lds_byte(int r, int c) { const int st = (r >> 4) * 2 + (c >> 5), rr = r & 15, cc = c & 31, ob = rr * 64 + cc * 2; return st * 1024 + (ob ^ (((ob >> 9) & 1) << 5)); }
__host__ __device__ __forceinline__ void stage_rc(int b, int& R, int& C) { const int st = b / 1024, sb = b % 1024, swz = sb ^ (((sb >> 9) & 1) << 5); R = (st >> 1) * 16 + swz / 64; C = (st & 1) * 32 + (swz % 64) / 2; }
__host__ __device__ __forceinline__ int perm32(int rho) { const int n = rho >> 4, i = rho & 15; return 8 * (i >> 2) + 4 * n + (i & 3); }

struct Unit { int pm, pn, e, lt, cnt, ms; };

template <int WGM_ = WGM> __device__ __forceinline__ bool order_map(int i, int G, int c, int nM, int nN, int& pm, int& pn) {
    const int nwg = nM * nN; const long L = (long)i * G + c; if (L >= nwg) return false;
    int wgid = (int)L; { const int q = nwg / NXCD, r = nwg % NXCD, xcd = wgid % NXCD, off = wgid / NXCD; wgid = (xcd < r ? xcd * (q + 1) : r * (q + 1) + (xcd - r) * q) + off; }
    const int nig = WGM_ * nN, gid = wgid / nig, fm = gid * WGM_, gsz = (nM - fm) < WGM_ ? (nM - fm) : WGM_;
    pm = fm + ((wgid % nig) % gsz); pn = (wgid % nig) / gsz; return true;
}
#ifndef FUSE_GD
#define FUSE_GD 1
#endif
constexpr int UTAB_OFF = 131072 + 3 * 2048, UTAB_N = 32;
constexpr int META_OFF = 131072, META_SLOT = 2048;
struct DenseSched {
    static constexpr bool GATHER = false, META = false;
    __device__ __forceinline__ void meta_dma(const Unit&, PG8_LAS unsigned char*, int, int) const {}
    const void* A; const void* Bt; int ldaB, KB, nM, nN, G, c;
    __device__ __forceinline__ bool next(int i, Unit& u) const { u.e = 0; u.lt = 0; u.cnt = 0; u.ms = 0; return order_map(i, G, c, nM, nN, u.pm, u.pn); }
    __device__ __forceinline__ bool next_lane(int i, Unit& u) const { return next(i, u); }
    __device__ __forceinline__ void signal(int, int) const {}
    __device__ __forceinline__ void wait_ready(int) const {}
    static constexpr int A_AUX = 0;
    __device__ __forceinline__ const char* a_base(const Unit& u) const { return (const char*)A + (size_t)u.pm * BM * ldaB; }
    __device__ __forceinline__ const char* b_base(const Unit& u) const { return (const char*)Bt + (size_t)u.pn * BM * KB; }
    __device__ __forceinline__ size_t a_hstep() const { return (size_t)HALF * ldaB; }
    __device__ __forceinline__ void a_offs(const Unit&, int tid, unsigned (&off)[2][2], PG8_LAS unsigned char*) const {
#pragma unroll
        for (int h = 0; h < 2; ++h)
#pragma unroll
            for (int i = 0; i < 2; ++i) { int R, C; stage_rc(tid * 16 + i * 8192, R, C); off[h][i] = (unsigned)((h * HALF + R) * ldaB + C * 2); }
    }
};
template <bool GATHER_> struct GroupedSched {
    static constexpr bool GATHER = GATHER_, META = true;
    static constexpr int A_AUX = (FUSE_GD && !GATHER_) ? 1 : 0;
    const void* A; const void* W; const int* list; const float* glist; const PG8_LAS int* tstart; const PG8_LAS int* cnt; int KB, N, nN, TM, G, c;
    int fused, r0, ntl, rk, nxc, kbase; unsigned* rdy;
    __device__ __forceinline__ bool map_unit(int i, int& pm, int& pn) const {
        if (!fused) return order_map<4>(i, G, c, TM, nN, pm, pn);
        const int kk = i * nxc + rk + kbase; if (kk < 0 || kk >= ntl * nN) return false;
        const int nig = 4 * nN, gid = kk / nig, fm = gid * 4, gsz = (ntl - fm) < 4 ? (ntl - fm) : 4;
        pm = r0 + fm + ((kk % nig) % gsz); pn = (kk % nig) / gsz; return true;
    }
    __device__ __forceinline__ void signal(int pm, int tid) const { if (fused && GATHER && tid == 0) (void)__hip_atomic_fetch_add(rdy + pm, 1u, __ATOMIC_RELAXED, __HIP_MEMORY_SCOPE_AGENT); }
    __device__ __forceinline__ void wait_ready(int pm) const {
        if (fused && !GATHER) { unsigned sp = 0; while (__hip_atomic_load(rdy + pm, __ATOMIC_RELAXED, __HIP_MEMORY_SCOPE_AGENT) < 8u) { __builtin_amdgcn_s_sleep(2); if (++sp > (1u << 20)) break; } } }
    __device__ __forceinline__ bool next(int i, Unit& u) const {
        if (!map_unit(i, u.pm, u.pn)) return false;
        int lo = 0, hi = 32;
#pragma unroll
        for (int s = 0; s < 5; ++s) { const int mid = (lo + hi) >> 1; const int v = __builtin_amdgcn_readfirstlane(tstart[mid]); if (v <= u.pm) lo = mid; else hi = mid; }
        u.e = lo; u.lt = u.pm - __builtin_amdgcn_readfirstlane(tstart[lo]); u.cnt = __builtin_amdgcn_readfirstlane(cnt[lo]); u.ms = (i % 3) * META_SLOT; return true;
    }
    __device__ __forceinline__ bool next_lane(int i, Unit& u) const {
        if (!map_unit(i, u.pm, u.pn)) return false;
        int lo = 0, hi = 32;
#pragma unroll
        for (int s = 0; s < 5; ++s) { const int mid = (lo + hi) >> 1; const int v = tstart[mid]; if (v <= u.pm) lo = mid; else hi = mid; }
        u.e = lo; u.lt = u.pm - tstart[lo]; u.cnt = cnt[lo]; u.ms = (i % 3) * META_SLOT; return true;
    }
    __device__ __forceinline__ void meta_dma(const Unit& u, PG8_LAS unsigned char* lds, int wid, int lane) const {
        const size_t src = (size_t)u.e * 32768 + (size_t)u.lt * BM + (wid & 3) * 64 + lane;
        const void* g = (wid < 4) ? (const void*)(list + src) : (const void*)(glist + src);
        __builtin_amdgcn_global_load_lds((const unsigned*)g, (PG8_LAS unsigned*)(lds + META_OFF + u.ms + (wid >> 2) * 1024 + (wid & 3) * 256), 4, 0, 0);
    }
    __device__ __forceinline__ const char* a_base(const Unit& u) const { return GATHER ? (const char*)A : (const char*)A + (size_t)u.pm * BM * KB; }
    __device__ __forceinline__ const char* b_base(const Unit& u) const { return (const char*)W + ((size_t)u.e * N + (size_t)u.pn * BM) * KB; }
    __device__ __forceinline__ size_t a_hstep() const { return (size_t)HALF * KB; }
    __device__ __forceinline__ void a_offs(const Unit& u, int tid, unsigned (&off)[2][2], PG8_LAS unsigned char* lds) const {
#pragma unroll
        for (int h = 0; h < 2; ++h)
#pragma unroll
            for (int i = 0; i < 2; ++i) { int R, C; stage_rc(tid * 16 + i * 8192, R, C);
                if (GATHER) { const int r = h * HALF + R; const int a = ((const PG8_LAS int*)(lds + META_OFF + u.ms))[r]; const int tok = (u.lt * BM + r < u.cnt) ? (a >> 2) : 0; off[h][i] = (unsigned)(tok * KB + C * 2); }
                else off[h][i] = (unsigned)((h * HALF + R) * KB + C * 2);
            }
    }
};

__device__ __forceinline__ unsigned cvt_pk_bf16(float lo, float hi) { unsigned r; asm volatile("v_cvt_pk_bf16_f32 %0, %1, %2" : "=v"(r) : "v"(lo), "v"(hi)); return r; }
__device__ __forceinline__ f32x2 gelu_pk(f32x2 v) {
    const f32x2 av = __builtin_elementwise_abs(v), d = av * 0.2316418882f + 1.0f;
    f32x2 t; t.x = __builtin_amdgcn_rcpf(d.x); t.y = __builtin_amdgcn_rcpf(d.y);
    f32x2 q = t * 0.5307027145f + (-0.7265760135f); q = q * t + 0.7107068705f; q = q * t + (-0.142248368f); q = q * t + 0.127414796f; q = q * t;
    const f32x2 s = (v * v) * (-0.72134752044f);
    f32x2 e; e.x = __builtin_amdgcn_exp2f(s.x); e.y = __builtin_amdgcn_exp2f(s.y);
    const f32x2 m = v * (q * e), r = v - m;
    f32x2 o; o.x = v.x < 0.f ? m.x : r.x; o.y = v.y < 0.f ? m.y : r.y; return o;
}
template <int ACT, int QKV> struct EpiBf16 {
    static constexpr bool PERM = true; static constexpr int NSTORE = 16, NPRE = 0, EID = 4;
    bf16_t* O; int ldc; bf16_t* O2; bf16_t* O3;
    struct Pre {};
    __device__ __forceinline__ void prefetch(Pre&, const Unit&, int, int, int) const {}
    __device__ __forceinline__ void init(f32x4 (&acc)[2][2][4][2], const Pre&) const {
#pragma unroll
        for (int a = 0; a < 2; ++a)
#pragma unroll
            for (int b = 0; b < 2; ++b)
#pragma unroll
                for (int m = 0; m < 4; ++m)
#pragma unroll
                    for (int n = 0; n < 2; ++n) acc[a][b][m][n] = (f32x4){0.f, 0.f, 0.f, 0.f};
    }
    __device__ __forceinline__ void operator()(const f32x4 (&acc)[2][2][4][2], const Unit& u, int wr, int wc, int fr, int fq, const Pre&) const {
        const int row0 = u.pm * BM + wr * 64 + fr; int colt = u.pn * BM; bf16_t* base = O; int ld = ldc;
        if (QKV) { if (u.pn == 4) { base = O2; ld = 256; colt = 0; } else if (u.pn == 5) { base = O3; ld = 256; colt = 0; } }
        const int col0 = colt + wc * 32 + 8 * fq;
#pragma unroll
        for (int ai = 0; ai < 2; ++ai)
#pragma unroll
            for (int m = 0; m < 4; ++m) { bf16_t* rowp = base + (size_t)(row0 + ai * HALF + m * 16) * ld + col0;
#pragma unroll
                for (int bj = 0; bj < 2; ++bj) { f32x4 v0 = acc[ai][bj][m][0], v1 = acc[ai][bj][m][1];
                    if (ACT == 1) { f32x2 a = gelu_pk((f32x2){v0[0], v0[1]}), b = gelu_pk((f32x2){v0[2], v0[3]}), c = gelu_pk((f32x2){v1[0], v1[1]}), d = gelu_pk((f32x2){v1[2], v1[3]});
                        v0 = (f32x4){a.x, a.y, b.x, b.y}; v1 = (f32x4){c.x, c.y, d.x, d.y}; }
                    u32x4 w; w.x = cvt_pk_bf16(v0[0], v0[1]); w.y = cvt_pk_bf16(v0[2], v0[3]); w.z = cvt_pk_bf16(v1[0], v1[1]); w.w = cvt_pk_bf16(v1[2], v1[3]);
                    *(u32x4*)(rowp + bj * HALF) = w; } }
    }
};
__device__ __forceinline__ float swiglu1(float g, float l) {
    g = fminf(g, 7.0f); l = fminf(fmaxf(l, -7.0f), 7.0f);
    const float s = __builtin_amdgcn_rcpf(1.0f + __builtin_amdgcn_exp2f(g * (-1.702f * 1.4426950408889634f)));
    return g * s * (l + 1.0f);
}
__device__ __forceinline__ float swiglu1b(float g, float l1) {
    g = fminf(g, 7.0f); l1 = __builtin_amdgcn_fmed3f(l1, -6.0f, 8.0f);
    const float s = __builtin_amdgcn_rcpf(1.0f + __builtin_amdgcn_exp2f(g * (-1.702f * 1.4426950408889634f)));
    return g * s * l1;
}
struct EpiSwiglu {
    static constexpr bool PERM = true; static constexpr int NSTORE = 8, NPRE = 0, EID = 0;
    bf16_t* Hm; const float* biasp;
    struct Pre {};
    __device__ __forceinline__ void prefetch(Pre&, const Unit&, int, int, int) const {}
    __device__ __forceinline__ void init(f32x4 (&acc)[2][2][4][2], const Pre&) const {
#pragma unroll
        for (int a = 0; a < 2; ++a)
#pragma unroll
            for (int b = 0; b < 2; ++b)
#pragma unroll
                for (int m = 0; m < 4; ++m)
#pragma unroll
                    for (int n = 0; n < 2; ++n) acc[a][b][m][n] = (f32x4){0.f, 0.f, 0.f, 0.f};
    }
    __device__ __forceinline__ void operator()(const f32x4 (&acc)[2][2][4][2], const Unit& u, int wr, int wc, int fr, int fq, const Pre&) const {
        const int row0 = u.pm * BM + wr * 64 + fr, col0 = u.pn * HALF + wc * 32 + 8 * fq;
        const float* bp = biasp + (size_t)u.e * 2048 + u.pn * BM + wc * 32 + 8 * fq;
        f32x4 bg[2], bl[2];
#pragma unroll
        for (int n = 0; n < 2; ++n) { bg[n] = *(const f32x4*)(bp + 4 * n); bl[n] = *(const f32x4*)(bp + HALF + 4 * n); }
#pragma unroll
        for (int ai = 0; ai < 2; ++ai)
#pragma unroll
            for (int m = 0; m < 4; ++m) { bf16_t* rowp = Hm + (size_t)(row0 + ai * HALF + m * 16) * 1024 + col0;
                float o[8];
#pragma unroll
                for (int n = 0; n < 2; ++n) { const f32x4 g = acc[ai][0][m][n] + bg[n], l = acc[ai][1][m][n] + bl[n];
#pragma unroll
                    for (int j = 0; j < 4; ++j) o[4 * n + j] = swiglu1(g[j], l[j]); }
                u32x4 w; w.x = cvt_pk_bf16(o[0], o[1]); w.y = cvt_pk_bf16(o[2], o[3]); w.z = cvt_pk_bf16(o[4], o[5]); w.w = cvt_pk_bf16(o[6], o[7]);
                *(u32x4*)rowp = w; }
    }
};
__device__ __forceinline__ unsigned pk4_fp8(float a, float b, float c, float d) { int w = 0; w = __builtin_amdgcn_cvt_pk_fp8_f32(a, b, w, false); w = __builtin_amdgcn_cvt_pk_fp8_f32(c, d, w, true); return (unsigned)w; }
struct EpiSwiglu8 {
    static constexpr bool PERM = true; static constexpr int NSTORE = 4, EID = 1;
    unsigned char* Hm; const float* biasp;
    static constexpr int NPRE = 4;
    struct Pre { f32x4 bg[2], bl[2]; };
    __device__ __forceinline__ void prefetch(Pre& p, const Unit& u, int wc, int fr, int fq) const {
        const float* bp = biasp + (size_t)u.e * 2048 + u.pn * BM + wc * 32 + 8 * fq;
#pragma unroll
        for (int n = 0; n < 2; ++n) { p.bg[n] = *(const f32x4*)(bp + 4 * n); p.bl[n] = *(const f32x4*)(bp + HALF + 4 * n); }
    }
    __device__ __forceinline__ void init(f32x4 (&acc)[2][2][4][2], const Pre& p) const {
#pragma unroll
        for (int a = 0; a < 2; ++a)
#pragma unroll
            for (int m = 0; m < 4; ++m)
#pragma unroll
                for (int n = 0; n < 2; ++n) { acc[a][0][m][n] = p.bg[n]; acc[a][1][m][n] = p.bl[n] + 1.0f; }
    }
    __device__ __forceinline__ void operator()(const f32x4 (&acc)[2][2][4][2], const Unit& u, int wr, int wc, int fr, int fq, const Pre&) const {
        const int row0 = u.pm * BM + wr * 64 + fr, col0 = u.pn * HALF + wc * 32 + 8 * fq;
        unsigned char* base = Hm + (size_t)(row0 + (fq & 1) * 16) * 1024 + (col0 - 8 * (fq & 1));
#pragma unroll
        for (int ai = 0; ai < 2; ++ai)
#pragma unroll
            for (int mp = 0; mp < 2; ++mp) {
                u32x2 w[2];
#pragma unroll
                for (int mm = 0; mm < 2; ++mm) { const int m = 2 * mp + mm;
                    float o[8];
#pragma unroll
                    for (int n = 0; n < 2; ++n) { const f32x4 g = acc[ai][0][m][n], l = acc[ai][1][m][n];
#pragma unroll
                        for (int j = 0; j < 4; ++j) o[4 * n + j] = swiglu1b(g[j], l[j]); }
                    w[mm].x = pk4_fp8(o[0], o[1], o[2], o[3]); w[mm].y = pk4_fp8(o[4], o[5], o[6], o[7]); }
                const auto sx = __builtin_amdgcn_permlane16_swap(w[0].x, w[1].x, false, false), sy = __builtin_amdgcn_permlane16_swap(w[0].y, w[1].y, false, false);
                u32x4 q; q.x = sx[0]; q.y = sy[0]; q.z = sx[1]; q.w = sy[1];
                *(u32x4*)(base + (size_t)(ai * HALF + mp * 32) * 1024) = q; }
    }
};
struct EpiDown {
    static constexpr int PERM = 2; static constexpr int NSTORE = 8, EID = 2;
    unsigned char* Y; const float* bias; PG8_LAS unsigned char* lds;
    static constexpr int NPRE = 4;
    struct Pre { f32x4 bv[2][2]; };
    __device__ __forceinline__ void prefetch(Pre& p, const Unit& u, int wc, int fr, int fq) const {
        const float* bp = bias + (size_t)u.e * 1024 + u.pn * BM + wc * 64 + 16 * fq;
#pragma unroll
        for (int bj = 0; bj < 2; ++bj) { p.bv[bj][0] = *(const f32x4*)(bp + bj * 8); p.bv[bj][1] = *(const f32x4*)(bp + bj * 8 + 4); }
    }
    __device__ __forceinline__ void init(f32x4 (&acc)[2][2][4][2], const Pre& p) const {
#pragma unroll
        for (int a = 0; a < 2; ++a)
#pragma unroll
            for (int b = 0; b < 2; ++b)
#pragma unroll
                for (int m = 0; m < 4; ++m)
#pragma unroll
                    for (int n = 0; n < 2; ++n) acc[a][b][m][n] = p.bv[b][n];
    }
    __device__ __forceinline__ void operator()(const f32x4 (&acc)[2][2][4][2], const Unit& u, int wr, int wc, int fr, int fq, const Pre&) const {
        const int lr0 = wr * 64 + fr, col0 = u.pn * BM + wc * 64 + 16 * fq;
        const PG8_LAS int* ids = (const PG8_LAS int*)(lds + META_OFF + u.ms); const PG8_LAS float* gts = (const PG8_LAS float*)(lds + META_OFF + u.ms + 1024);
#pragma unroll
        for (int ai = 0; ai < 2; ++ai)
#pragma unroll
            for (int m = 0; m < 4; ++m) { const int lr = lr0 + ai * HALF + m * 16;
                int a = ids[lr]; a = (u.lt * BM + lr < u.cnt) ? a : 131072;
                const float g = gts[lr] * 64.0f; unsigned char* rowp = Y + (size_t)a * 1024 + col0;
                u32x4 w;
#pragma unroll
                for (int bj = 0; bj < 2; ++bj) {
                    const f32x4 v0 = acc[ai][bj][m][0] * g, v1 = acc[ai][bj][m][1] * g;
                    w[2 * bj] = pk4_fp8(v0[0], v0[1], v0[2], v0[3]); w[2 * bj + 1] = pk4_fp8(v1[0], v1[1], v1[2], v1[3]); }
                *(u32x4*)rowp = w;
                asm volatile("" ::: "memory"); }
    }
};

template <bool FP8, class Epi, class Sched>
__device__ __forceinline__ void gemm_phase(PG8_LAS unsigned char* lds, const int KB  , const Sched& S, const Epi& E, const int tid, const int wscale = 0x7F7F7F7F, const int ascale = 0x7F7F7F7F) {
    const int wid = __builtin_amdgcn_readfirstlane(tid >> 6), lane = tid & 63, wr = wid >> 2, wc = wid & 3, fr = lane & 15, fq = lane >> 4;
    const int nt = KB / 128;
    unsigned voffB[2];
#pragma unroll
    for (int i = 0; i < 2; ++i) { int R, C; stage_rc(tid * 16 + i * 8192, R, C); const int Rb = (int)Epi::PERM == 2 ? (64 * (R >> 5) + 16 * ((R & 15) >> 2) + 4 * ((R >> 4) & 1) + (R & 3)) : Epi::PERM ? ((R & ~31) + perm32(R & 31)) : R; voffB[i] = (unsigned)(Rb * KB + C * 2); }
    const size_t kstep = (size_t)(BK * 2);
    const size_t hstep = (size_t)((int)Epi::PERM == 2 ? 8 : HALF) * KB;
    const size_t hstepA = S.a_hstep();
    const unsigned ldsw = (unsigned)wid * 1024u;
    const int aoff = lds_byte(wr * 64 + fr, fq * 8), boff = lds_byte(wc * 32 + fr, fq * 8);
#define PG8_SA(b, h) (((b) * 2 + (h)) * HTB)
#define PG8_SB(b, h) ((4 + (b) * 2 + (h)) * HTB)
#define PG8_STAGE(bufoff, gbase, voff) do { _Pragma("unroll") for (int _i = 0; _i < 2; ++_i) \
        __builtin_amdgcn_global_load_lds((const unsigned*)((const char*)(gbase) + (voff)[_i]), (PG8_LAS unsigned*)(lds + (bufoff) + ldsw + _i * 8192), 16, 0, 0); } while (0)
#define PG8_STAGE_X(bufoff, gbase, voff) do { _Pragma("unroll") for (int _i = 0; _i < 2; ++_i) \
        __builtin_amdgcn_global_load_lds((const unsigned*)((const char*)(gbase) + (voff)[_i]), (PG8_LAS unsigned*)(lds + (bufoff) + ldsw + _i * 8192), 16, 0, Sched::A_AUX); } while (0)
#define PG8_STAGE_A(bufoff, gbase, offs, half) do { if (Sched::GATHER) PG8_STAGE(bufoff, gbase, (offs)[half]); else PG8_STAGE_X(bufoff, (gbase) + (half) * hstepA, (offs)[0]); } while (0)
#define PG8_LD8(p) __builtin_shufflevector(*(const PG8_LAS v4i32_t*)(p), *(const PG8_LAS v4i32_t*)((p) + 1024), 0, 1, 2, 3, 4, 5, 6, 7)
#define PG8_LDA(dst, b, h) do { _Pragma("unroll") for (int m = 0; m < 4; ++m) dst[m] = PG8_LD8(lds + PG8_SA(b, h) + aoff + m * 2048); } while (0)
#define PG8_LDB(dst, b, h) do { _Pragma("unroll") for (int n = 0; n < 2; ++n) dst[n] = PG8_LD8(lds + PG8_SB(b, h) + boff + n * 2048); } while (0)
#define PG8_HALF(x, k) __builtin_bit_cast(bf16x8, (k) ? __builtin_shufflevector((x), (x), 4, 5, 6, 7) : __builtin_shufflevector((x), (x), 0, 1, 2, 3))
#define PG8_MMA(ai, bj, At, Bt) do { __builtin_amdgcn_s_setprio(1); _Pragma("unroll") for (int m = 0; m < 4; ++m) _Pragma("unroll") for (int n = 0; n < 2; ++n) { \
        if constexpr (FP8) asm volatile("v_mfma_scale_f32_16x16x128_f8f6f4 %0, %1, %2, %0, %3, %4 op_sel_hi:[0,0,0]" : "+v"(acc[ai][bj][m][n]) : "v"(Bt[n]), "v"(At[m]), "v"(wsc_v), "v"(one_v));     \
        else { _Pragma("unroll") for (int k = 0; k < 2; ++k) acc[ai][bj][m][n] = __builtin_amdgcn_mfma_f32_16x16x32_bf16(PG8_HALF(Bt[n], k), PG8_HALF(At[m], k), acc[ai][bj][m][n], 0, 0, 0); } } \
        __builtin_amdgcn_s_setprio(0); } while (0)
#define PG8_WAIT_V(n) asm volatile("s_waitcnt vmcnt(" #n ")" ::: "memory")
#define PG8_WAIT_VX(n, fresh) do { if (fresh) asm volatile("s_waitcnt vmcnt(%0)" :: "n"((n) + Epi::NSTORE + (Sched::META ? 1 : 0)) : "memory"); else PG8_WAIT_V(n); } while (0)
#define PG8_WAIT_L(n) asm volatile("s_waitcnt lgkmcnt(" #n ")" ::: "memory")
#define PG8_BAR __builtin_amdgcn_s_barrier()
#define PG8_SCHED __builtin_amdgcn_sched_barrier(0)
    PG8_LAS int* utab = (PG8_LAS int*)(lds + UTAB_OFF);
    if (tid < UTAB_N) { Unit tu; const bool ok = S.next_lane(tid, tu); v4i32_t t4; t4.x = ok ? tu.pm : -1; t4.y = tu.pn; t4.z = tu.e; t4.w = tu.lt; *(PG8_LAS v4i32_t*)(utab + tid * 8) = t4; utab[tid * 8 + 4] = tu.cnt; }
    __syncthreads();
#define PG8_NEXT(i, u) ([&]() -> bool { if ((i) >= UTAB_N) return S.next((i), (u)); const v4i32_t t4 = *(const PG8_LAS v4i32_t*)(utab + (i) * 8); const int pm_ = __builtin_amdgcn_readfirstlane(t4.x); if (pm_ < 0) return false; \
        (u).pm = pm_; (u).pn = __builtin_amdgcn_readfirstlane(t4.y); (u).e = __builtin_amdgcn_readfirstlane(t4.z); (u).lt = __builtin_amdgcn_readfirstlane(t4.w); (u).cnt = __builtin_amdgcn_readfirstlane(utab[(i) * 8 + 4]); (u).ms = Sched::META ? ((i) % 3) * META_SLOT : 0; return true; }())
    Unit cur, nxt; int ui = 0, prev_pm = 0;
    if (!PG8_NEXT(0, cur)) return;
    S.wait_ready(cur.pm);
    f32x4 acc[2][2][4][2];
    typename Epi::Pre pre; E.prefetch(pre, cur, wc, fr, fq); E.init(acc, pre);
    v8i32_t At[4], B0[2], B1[2];
    int wsc_v = wscale, one_v = ascale; asm volatile("" : "+v"(wsc_v), "+v"(one_v));
    unsigned offC[2][2];
    if constexpr (Sched::META) { S.meta_dma(cur, lds, wid, lane); PG8_WAIT_V(0); PG8_BAR; }
    S.a_offs(cur, tid, offC, lds);
    const char* cA = S.a_base(cur); const char* cB = S.b_base(cur);
    PG8_STAGE(PG8_SB(0, 0), cB, voffB); PG8_STAGE(PG8_SB(0, 1), cB + hstep, voffB); PG8_STAGE_A(PG8_SA(0, 0), cA, offC, 0); PG8_STAGE_A(PG8_SA(0, 1), cA, offC, 1);
    if (wr == 1) PG8_BAR;
    PG8_WAIT_V(2); PG8_BAR;
    PG8_STAGE(PG8_SB(1, 0), cB + kstep, voffB); PG8_STAGE_A(PG8_SA(1, 0), cA + kstep, offC, 0); PG8_STAGE(PG8_SB(1, 1), cB + hstep + kstep, voffB);
    PG8_WAIT_V(6); PG8_BAR;
    for (;;) {
        const bool has_next = PG8_NEXT(ui + 1, nxt);
        if (has_next) S.wait_ready(nxt.pm);
        const char* nA = has_next ? S.a_base(nxt) : cA; const char* nB = has_next ? S.b_base(nxt) : cB;
        if constexpr (Sched::META) { if (has_next) S.meta_dma(nxt, lds, wid, lane); }
#pragma unroll 1
        for (int t = 0; t < nt; t += 2) {
            const bool last = (t == nt - 2); const bool fresh = (t == 0) && (ui > 0);
            const char* a1 = cA + (size_t)(t + 1) * kstep;
            const char* a2 = last ? nA : cA + (size_t)(t + 2) * kstep; const char* b2 = last ? nB : cB + (size_t)(t + 2) * kstep;
            const char* a3 = a2 + kstep; const char* b3 = b2 + kstep;
            PG8_LDB(B0, 0, 0); PG8_LDB(B1, 0, 1); PG8_SCHED; PG8_LDA(At, 0, 0); if (!fresh) PG8_STAGE_A(PG8_SA(1, 1), a1, offC, 1);
            if (Sched::GATHER && last && has_next) S.a_offs(nxt, tid, offC, lds);
            PG8_WAIT_VX(8, fresh); PG8_WAIT_L(0); PG8_BAR; PG8_MMA(0, 0, At, B0); PG8_MMA(0, 1, At, B1); PG8_BAR; PG8_SCHED;
            PG8_LDA(At, 0, 1); PG8_STAGE(PG8_SB(0, 0), b2, voffB); PG8_STAGE(PG8_SB(0, 1), b2 + hstep, voffB); PG8_STAGE_A(PG8_SA(0, 0), a2, offC, 0);
            if (fresh) { PG8_WAIT_VX(14, true); } else { PG8_WAIT_V(8); }
            PG8_WAIT_L(0); PG8_BAR; PG8_MMA(1, 0, At, B0); PG8_MMA(1, 1, At, B1); PG8_BAR; PG8_SCHED;
            PG8_LDB(B0, 1, 0); PG8_LDB(B1, 1, 1); PG8_SCHED; PG8_LDA(At, 1, 0); PG8_STAGE_A(PG8_SA(0, 1), a2, offC, 1);
            if (fresh) { PG8_WAIT_VX(10, true); } else { PG8_WAIT_V(8); }
            PG8_WAIT_L(0); PG8_BAR; PG8_MMA(0, 0, At, B0); PG8_MMA(0, 1, At, B1); PG8_BAR; PG8_SCHED;
            PG8_LDA(At, 1, 1); PG8_STAGE(PG8_SB(1, 0), b3, voffB); PG8_STAGE(PG8_SB(1, 1), b3 + hstep, voffB); PG8_STAGE_A(PG8_SA(1, 0), a3, offC, 0);
            if (fresh) { PG8_WAIT_VX(14, true); } else { PG8_WAIT_V(8); }
            PG8_WAIT_L(0); PG8_BAR; PG8_MMA(1, 0, At, B0); PG8_MMA(1, 1, At, B1); PG8_BAR; PG8_SCHED;
        }
        if (has_next) E.prefetch(pre, nxt, wc, fr, fq);
        if (has_next) PG8_STAGE_A(PG8_SA(1, 1), nA + kstep, offC, 1);
        if (wr == 0) PG8_BAR;
        if (ui > 0) S.signal(prev_pm, tid);
        if constexpr (FP8) asm volatile("s_nop 15\n\ts_nop 7" ::: "memory");
        E(acc, cur, wr, wc, fr, fq, pre);
#ifdef DUP_EPI
        if constexpr ((DUP_EPI & Epi::EID) != 0) {
#pragma unroll
            for (int a = 0; a < 2; ++a)
#pragma unroll
                for (int b = 0; b < 2; ++b)
#pragma unroll
                    for (int m = 0; m < 4; ++m)
#pragma unroll
                        for (int n = 0; n < 2; ++n) asm volatile("" : "+v"(acc[a][b][m][n]));
            E(acc, cur, wr, wc, fr, fq, pre);
        }
#endif
        if (!has_next) break;
        E.init(acc, pre);
        prev_pm = cur.pm; cur = nxt; cA = nA; cB = nB; ++ui;
        if (wr == 1) PG8_BAR;
    }
    PG8_WAIT_V(0);
    PG8_BAR;
    S.signal(cur.pm, tid);
#undef PG8_SA
#undef PG8_SB
#undef PG8_STAGE
#undef PG8_STAGE_A
#undef PG8_STAGE_X
#undef PG8_LDA
#undef PG8_LDB
#undef PG8_MMA
#undef PG8_LD8
#undef PG8_HALF
#undef PG8_WAIT_V
#undef PG8_NEXT
#undef PG8_WAIT_VX
#undef PG8_WAIT_L
#undef PG8_BAR
#undef PG8_SCHED
}
}

#include <hip/hip_bf16.h>
namespace attn_body {
using bf16=__hip_bfloat16;
using bf16x8=__attribute__((ext_vector_type(8)))short;
using s16x4=__attribute__((ext_vector_type(4)))short;
using f32x16=__attribute__((ext_vector_type(16)))float;
using u32x4=__attribute__((ext_vector_type(4)))unsigned;
constexpr int BATCH=8,NHEAD=16,SEQ=4096,D=64,DM=NHEAD*D,KP=256;
constexpr int NW=8,QBLK=32,QB=QBLK*NW,KVBLK=64,NQB=SEQ/QB;
constexpr int ATTN_PITCH=DM, ATTN_UNIT_ROWS=QB;
__device__ __forceinline__ int crow(int r,int hi){return (r&3)+8*(r>>2)+4*hi;}
#define SBAR() __builtin_amdgcn_sched_barrier(0)
__device__ __forceinline__ void cmask(f32x16&p0,f32x16&p1,int jb,int qrel,int hi){
  const float NEG=-INFINITY; int kb=64*jb+4*hi;
  #pragma unroll
  for(int r=0;r<16;++r){int kv=kb+(r&3)+8*(r>>2); if(kv>qrel)p0[r]=NEG; if(kv+32>qrel)p1[r]=NEG;}
}

constexpr int NSLOT=3, SLOTB=8192;
constexpr int LDS_K=0, LDS_V=NSLOT*SLOTB, LDS_WS=2*NSLOT*SLOTB, LDS_OST=LDS_WS+NW*64*4, LDS_BYTES=LDS_OST+NW*4096;
constexpr float C2=0.125f*1.4426950408889634f;
__device__ __forceinline__ void glds16(const void*gsrc,unsigned lds_dst){unsigned keep;
  asm volatile("s_mov_b32 %0, m0\n\ts_mov_b32 m0, %2\n\ts_nop 0\n\tglobal_load_lds_dwordx4 %1, off\n\ts_mov_b32 m0, %0":"=&s"(keep):"v"(gsrc),"s"(lds_dst):"memory");}
__device__ __forceinline__ float max3f(float a,float b,float c){float r;asm("v_max3_f32 %0, %1, %2, %3":"=v"(r):"v"(a),"v"(b),"v"(c));return r;}
__device__ __forceinline__ float max2f(float a,float b){float r;asm("v_max_f32_e32 %0, %1, %2":"=v"(r):"v"(a),"v"(b));return r;}
__device__ __forceinline__ float fadd_s(float a,float b){float r;asm("v_add_f32_e32 %0, %1, %2":"=v"(r):"v"(a),"v"(b));return r;}
__device__ __forceinline__ float fsub_s(float a,float b){float r;asm("v_sub_f32_e32 %0, %1, %2":"=v"(r):"v"(a),"v"(b));return r;}
typedef float f32x2_t __attribute__((ext_vector_type(2))); typedef __bf16 bf16x2_t __attribute__((ext_vector_type(2)));
__device__ __forceinline__ unsigned cvtpk_s(float lo,float hi){f32x2_t v={lo,hi};bf16x2_t b=__builtin_convertvector(v,bf16x2_t);return __builtin_bit_cast(unsigned,b);}
#define WAIT_BAR(N) asm volatile("s_waitcnt vmcnt(" #N ") lgkmcnt(0)\n\ts_barrier":::"memory")

__device__ __forceinline__ void qkt(f32x16&p0,f32x16&p1,const char*Kslot,const bf16x8*qr,const f32x16&negm,int r32,int hi){
  const char*kb=Kslot+hi*1024+r32*16;
  #pragma unroll
  for(int d0=0;d0<4;++d0){
    const bf16x8 b0=*reinterpret_cast<const bf16x8*>(kb+d0*2048);
    const bf16x8 b1=*reinterpret_cast<const bf16x8*>(kb+d0*2048+512);
    if(d0==0){p0=__builtin_amdgcn_mfma_f32_32x32x16_bf16(b0,qr[0],negm,0,0,0);p1=__builtin_amdgcn_mfma_f32_32x32x16_bf16(b1,qr[0],negm,0,0,0);}
    else{p0=__builtin_amdgcn_mfma_f32_32x32x16_bf16(b0,qr[d0],p0,0,0,0);p1=__builtin_amdgcn_mfma_f32_32x32x16_bf16(b1,qr[d0],p1,0,0,0);}}
}
typedef __attribute__((address_space(3))) const char* lds_cptr;
typedef short v4i16_t __attribute__((ext_vector_type(4)));
__device__ __forceinline__ void kload8(bf16x8*kf,lds_cptr kp){
  kf[0]=*(const __attribute__((address_space(3))) bf16x8*)(kp);      kf[1]=*(const __attribute__((address_space(3))) bf16x8*)(kp+512);
  kf[2]=*(const __attribute__((address_space(3))) bf16x8*)(kp+2048); kf[3]=*(const __attribute__((address_space(3))) bf16x8*)(kp+2560);
  kf[4]=*(const __attribute__((address_space(3))) bf16x8*)(kp+4096); kf[5]=*(const __attribute__((address_space(3))) bf16x8*)(kp+4608);
  kf[6]=*(const __attribute__((address_space(3))) bf16x8*)(kp+6144); kf[7]=*(const __attribute__((address_space(3))) bf16x8*)(kp+6656);
}
__device__ __forceinline__ void kload2(bf16x8*kf,lds_cptr kp,int j){ kf[2*j]=*(const __attribute__((address_space(3))) bf16x8*)(kp+j*2048); kf[2*j+1]=*(const __attribute__((address_space(3))) bf16x8*)(kp+j*2048+512); }
__device__ __forceinline__ s16x4 vtr(lds_cptr p){ return __builtin_bit_cast(s16x4,__builtin_amdgcn_ds_read_tr16_b64_v4i16((__attribute__((address_space(3))) v4i16_t*)p)); }
__device__ __forceinline__ float rowmax(const f32x16&p0,const f32x16&p1){
  float a=max3f(p0[0],p0[1],p1[0]),b=max3f(p0[2],p0[3],p1[1]);a=max3f(a,p1[2],p1[3]);
  #pragma unroll
  for(int r=4;r<16;r+=4){a=max3f(a,p0[r],p0[r+1]);b=max3f(b,p0[r+2],p0[r+3]);a=max3f(a,p1[r],p1[r+1]);b=max3f(b,p1[r+2],p1[r+3]);}
  const float m=max2f(a,b);
  auto rr=__builtin_amdgcn_permlane32_swap(__float_as_uint(m),__float_as_uint(m),false,false);
  return max2f(__uint_as_float(rr[0]),__uint_as_float(rr[1]));
}
__device__ __forceinline__ void pv(f32x16*o,int vb,bf16x8 pa0,bf16x8 pa1,bf16x8 pa2,bf16x8 pa3){
  #pragma unroll
  for(int d0=0;d0<2;++d0){s16x4 lo[4],hi[4];
    #pragma unroll
    for(int ks=0;ks<4;++ks){
      asm volatile("ds_read_b64_tr_b16 %0,%1 offset:%c2":"=&v"(lo[ks]):"v"(vb),"i"(d0*4096+ks*1024):"memory");
      asm volatile("ds_read_b64_tr_b16 %0,%1 offset:%c2":"=&v"(hi[ks]):"v"(vb),"i"(d0*4096+ks*1024+512):"memory");}
    asm volatile("s_waitcnt lgkmcnt(0)":::"memory");SBAR();
    #define PK(k) (bf16x8){lo[k][0],lo[k][1],lo[k][2],lo[k][3],hi[k][0],hi[k][1],hi[k][2],hi[k][3]}
    o[d0]=__builtin_amdgcn_mfma_f32_32x32x16_bf16(pa0,PK(0),o[d0],0,0,0);
    o[d0]=__builtin_amdgcn_mfma_f32_32x32x16_bf16(pa1,PK(1),o[d0],0,0,0);
    o[d0]=__builtin_amdgcn_mfma_f32_32x32x16_bf16(pa2,PK(2),o[d0],0,0,0);
    o[d0]=__builtin_amdgcn_mfma_f32_32x32x16_bf16(pa3,PK(3),o[d0],0,0,0);
    #undef PK
  }
}

#ifndef ATTN_STORE16
#define ATTN_STORE16(p,v) (*(u32x4*)(p)=(v))
#endif
template<int THRL> __device__ __forceinline__ void attn_unit(int b,int h,int qb,const bf16*Q,const bf16*__restrict__ K,const bf16*__restrict__ V,bf16*O,char*shm,const int tid,const float m0){
  const int lane=tid&63,r32=lane&31,hi=lane>>5; const int wid=__builtin_amdgcn_readfirstlane(tid>>6);
  const long rowbase=(long)b*SEQ; const int q0=qb*QB;
  const bf16*Qw=Q+(rowbase+q0+wid*QBLK)*DM+h*D;
  const bf16*Kh=K+rowbase*KP+(h>>2)*D,*Vh=V+rowbase*KP+(h>>2)*D;
  const unsigned lds0=(unsigned)(uintptr_t)shm;
  float*wsf=(float*)(shm+LDS_WS)+wid*64;
  const bf16*ksrc=Kh+(long)lane*KP+wid*8;
  const bf16*vsrc=Vh+(long)(16*(wid&3)+(lane>>2))*KP+(wid>>2)*32+(lane&3)*8;
  const unsigned kdst=lds0+LDS_K+wid*1024, vdst=lds0+LDS_V+wid*1024;
  #define DMA_K(t,slot) glds16(ksrc+(long)(t)*KVBLK*KP,(unsigned)__builtin_amdgcn_readfirstlane(kdst+(slot)))
  #define DMA_V(t,slot) glds16(vsrc+(long)(t)*KVBLK*KP,(unsigned)__builtin_amdgcn_readfirstlane(vdst+(slot)))
  const int vb0=(int)(lds0+LDS_V)+((lane>>4)&1)*32+(lane&3)*8+(4*hi+((lane&15)>>2))*64;
  const char*Kbase=shm+LDS_K; bf16x8 kf[8];
  const lds_cptr shm3=(lds_cptr)shm; const lds_cptr kp0=shm3+LDS_K+hi*1024+r32*16; const lds_cptr vp0=shm3+LDS_V+((lane>>4)&1)*32+(lane&3)*8+(4*hi+((lane&15)>>2))*64;
  constexpr int NT=SEQ/KVBLK;
  DMA_K(0,0);DMA_V(0,0);DMA_K(1,SLOTB);
  bf16x8 qr[4];
  #pragma unroll
  for(int d0=0;d0<4;++d0)qr[d0]=*reinterpret_cast<const bf16x8*>(&Qw[(long)r32*DM+d0*16+hi*8]);
  float l_reg=0.f;float zf=0.f;asm volatile("":"+v"(zf));f32x16 o[2];
  #pragma unroll
  for(int r=0;r<16;++r){o[0][r]=zf;o[1][r]=zf;}
  f32x16 negm;
  #pragma unroll
  for(int r=0;r<16;++r)negm[r]=zf-m0;
  asm volatile("":"+v"(negm));
  const int qrel=wid*QBLK+r32;
  #define CMASK(P0,P1,t) do{}while(0)
  #define START(P0,P1) do{ _Pragma("unroll") for(int r=0;r<16;++r)P0[r]=__builtin_amdgcn_exp2f(P0[r]); }while(0)
  #define RESC() do{}while(0)
  f32x16 pA0,pA1,pB0,pB1;
  int sl_prev=0,sl_cur=0,sl_next=SLOTB;
  #define ROT() do{sl_prev=sl_cur;sl_cur=sl_next;sl_next=(sl_next==(NSLOT-1)*SLOTB)?0:sl_next+SLOTB;}while(0)
  DMA_K(2,2*SLOTB);
  WAIT_BAR(3);
  qkt(pA0,pA1,Kbase,qr,negm,r32,hi);asm volatile("s_nop 15\n\ts_nop 7":"+v"(pA0),"+v"(pA1));CMASK(pA0,pA1,0);
  START(pA0,pA1);
  _Pragma("unroll") for(int r=0;r<16;++r)pA1[r]=__builtin_amdgcn_exp2f(pA1[r]);
  WAIT_BAR(0);
  DMA_K(3,0);DMA_V(1,SLOTB);
  ROT();
  kload8(kf,kp0+sl_cur);
  WAIT_BAR(2);
  s16x4 vlo[8],vhi[8]; u32x4 pw0,pw1,pw2,pw3;
  #define PKW(P,B) cvtpk_s(P[B],P[B+1])
  #define PAF(k) __builtin_bit_cast(bf16x8,pw##k)
  #define VFR(i) (bf16x8){vlo[i][0],vlo[i][1],vlo[i][2],vlo[i][3],vhi[i][0],vhi[i][1],vhi[i][2],vhi[i][3]}
  #define PIN(x) asm volatile("":"+v"(x))
  #define MX3(a,b,c) __builtin_fmaxf(__builtin_fmaxf((a),(b)),(c))
  #define GAPA(MF,A0,A1,A2,A3,W0,W1,PW) do{ MF; sacc+=A0; sacc+=A1; sacc+=A2; sacc+=A3; PIN(sacc); W0; W1; PIN(PW); SBAR(); }while(0)
  #define EX(v) __builtin_amdgcn_exp2f(v)
  #define GAPB(MF,X,B) do{ MF; X[B]=EX(X[B]); X[B+1]=EX(X[B+1]); X[B+2]=EX(X[B+2]); X[B+3]=EX(X[B+3]); PIN(X); SBAR(); }while(0)
  #define VRD(i) do{ vlo[i]=vtr(vp_+(((i)>>2)*4096+((i)&3)*1024)); vhi[i]=vtr(vp_+(((i)>>2)*4096+((i)&3)*1024+512)); }while(0)
  #define KRD(G,j) do{ if(G){ kload2(kf,kp0+sl_next,j); SBAR(); } }while(0)
  #define STEP(C0,C1,P0,P1,t,GK,GV,GL) do{ SBAR(); \
    const lds_cptr vp_=vp0+sl_prev; \
    VRD(0); SBAR(); float sacc=(P0[0]+P0[1]); \
    GAPA(C0=__builtin_amdgcn_mfma_f32_32x32x16_bf16(kf[0],qr[0],negm,0,0,0), P0[2],P0[3],P0[4],P0[5],     pw0[0]=PKW(P0,0), pw0[1]=PKW(P0,2), pw0); \
    VRD(4); SBAR(); GAPA(C1=__builtin_amdgcn_mfma_f32_32x32x16_bf16(kf[1],qr[0],negm,0,0,0), P0[6],P0[7],P0[8],P0[9],     pw0[2]=PKW(P0,4), pw0[3]=PKW(P0,6), pw0); \
    VRD(1); SBAR(); GAPA(C0=__builtin_amdgcn_mfma_f32_32x32x16_bf16(kf[2],qr[1],C0,0,0,0),   P0[10],P0[11],P0[12],P0[13], pw1[0]=PKW(P0,8), pw1[1]=PKW(P0,10), pw1); \
    VRD(5); SBAR(); GAPA(C1=__builtin_amdgcn_mfma_f32_32x32x16_bf16(kf[3],qr[1],C1,0,0,0),   P0[14],P0[15],P1[0],P1[1],   pw1[2]=PKW(P0,12),pw1[3]=PKW(P0,14), pw1); \
    VRD(2); SBAR(); GAPA(C0=__builtin_amdgcn_mfma_f32_32x32x16_bf16(kf[4],qr[2],C0,0,0,0),   P1[2],P1[3],P1[4],P1[5],     pw2[0]=PKW(P1,0), pw2[1]=PKW(P1,2), pw2); \
    VRD(6); SBAR(); GAPA(C1=__builtin_amdgcn_mfma_f32_32x32x16_bf16(kf[5],qr[2],C1,0,0,0),   P1[6],P1[7],P1[8],P1[9],     pw2[2]=PKW(P1,4), pw2[3]=PKW(P1,6), pw2); \
    VRD(3); SBAR(); GAPA(C0=__builtin_amdgcn_mfma_f32_32x32x16_bf16(kf[6],qr[3],C0,0,0,0),   P1[10],P1[11],P1[12],P1[13], pw3[0]=PKW(P1,8), pw3[1]=PKW(P1,10), pw3); \
    VRD(7); SBAR(); GAPA(C1=__builtin_amdgcn_mfma_f32_32x32x16_bf16(kf[7],qr[3],C1,0,0,0),   P1[14],P1[15],0.f,0.f,       pw3[2]=PKW(P1,12),pw3[3]=PKW(P1,14), pw3); \
    l_reg+=sacc; \
    if(GK){DMA_K((t)+3,sl_cur);} if(GV){DMA_V((t)+1,sl_next);} \
    CMASK(C0,C1,t); \
    SBAR(); \
    GAPB(o[0]=__builtin_amdgcn_mfma_f32_32x32x16_bf16(PAF(0),VFR(0),o[0],0,0,0), C0,0); \
    GAPB(o[1]=__builtin_amdgcn_mfma_f32_32x32x16_bf16(PAF(0),VFR(4),o[1],0,0,0), C0,4); \
    KRD(GL,0); GAPB(o[0]=__builtin_amdgcn_mfma_f32_32x32x16_bf16(PAF(1),VFR(1),o[0],0,0,0), C0,8); \
    KRD(GL,1); GAPB(o[1]=__builtin_amdgcn_mfma_f32_32x32x16_bf16(PAF(1),VFR(5),o[1],0,0,0), C0,12); \
    KRD(GL,2); GAPB(o[0]=__builtin_amdgcn_mfma_f32_32x32x16_bf16(PAF(2),VFR(2),o[0],0,0,0), C1,0); \
    KRD(GL,3); GAPB(o[1]=__builtin_amdgcn_mfma_f32_32x32x16_bf16(PAF(2),VFR(6),o[1],0,0,0), C1,4); \
    GAPB(o[0]=__builtin_amdgcn_mfma_f32_32x32x16_bf16(PAF(3),VFR(3),o[0],0,0,0), C1,8); \
    GAPB(o[1]=__builtin_amdgcn_mfma_f32_32x32x16_bf16(PAF(3),VFR(7),o[1],0,0,0), C1,12); \
    }while(0)
  int t=1;
  #undef CMASK
  #define CMASK(P0,P1,t) do{}while(0)
  for(;t+5<NT;t+=2){
    STEP(pB0,pB1,pA0,pA1,t,true,true,true);     WAIT_BAR(2); RESC(); ROT();
    STEP(pA0,pA1,pB0,pB1,t+1,true,true,true);   WAIT_BAR(2); RESC(); ROT();
  }
  #undef CMASK
  #define CMASK(P0,P1,t) do{}while(0)
  #define ENDW(tt) do{ if((tt)+3<NT){WAIT_BAR(2);} else if((tt)+2<NT){WAIT_BAR(1);} else {WAIT_BAR(0);} }while(0)
  for(;t+1<NT;t+=2){
    STEP(pB0,pB1,pA0,pA1,t,(t+3<NT),(t+1<NT),(t+1<NT));       ENDW(t);   RESC(); ROT();
    STEP(pA0,pA1,pB0,pB1,t+1,(t+4<NT),(t+2<NT),(t+2<NT));     ENDW(t+1); RESC(); ROT();
  }
  STEP(pB0,pB1,pA0,pA1,NT-1,false,false,false); RESC();
  { float sacc=pB0[0]+pB0[1]; _Pragma("unroll") for(int r=2;r<16;++r)sacc+=pB0[r]; _Pragma("unroll") for(int r=0;r<16;++r)sacc+=pB1[r]; l_reg+=sacc;
    pw0=(u32x4){PKW(pB0,0),PKW(pB0,2),PKW(pB0,4),PKW(pB0,6)};pw1=(u32x4){PKW(pB0,8),PKW(pB0,10),PKW(pB0,12),PKW(pB0,14)};pw2=(u32x4){PKW(pB1,0),PKW(pB1,2),PKW(pB1,4),PKW(pB1,6)};pw3=(u32x4){PKW(pB1,8),PKW(pB1,10),PKW(pB1,12),PKW(pB1,14)};
    SBAR(); pv(o,vb0+sl_cur,PAF(0),PAF(1),PAF(2),PAF(3)); }
  #undef PKW
  #undef PAF
  #undef VFR
  #undef PIN
  #undef MX3
  #undef GAPA
  #undef GAPB
  #undef EX
  #undef VRD
  #undef KRD
  #undef STEP
  #undef ENDW
  {auto rr=__builtin_amdgcn_permlane32_swap(__float_as_uint(l_reg),__float_as_uint(l_reg),false,false);l_reg=__uint_as_float(rr[0])+__uint_as_float(rr[1]);}
  if(hi==0)wsf[32+r32]=l_reg;asm volatile("s_waitcnt lgkmcnt(0)":::"memory");
  float rli[16];
  #pragma unroll
  for(int r=0;r<16;++r)rli[r]=__builtin_amdgcn_rcpf(wsf[32+crow(r,hi)]);
  unsigned char*Ow=(unsigned char*)O+(rowbase+q0+wid*QBLK)*DM+h*D;
  { unsigned char*stg=(unsigned char*)(shm+LDS_OST)+wid*4096;
    #pragma unroll
    for(int r=0;r<16;++r){const int orow=crow(r,hi); const float sc=rli[r]*64.0f;
      #pragma unroll
      for(int d0=0;d0<2;++d0){const float val=o[d0][r]*sc; stg[orow*64+d0*32+r32]=(unsigned char)(__builtin_amdgcn_cvt_pk_fp8_f32(val,val,0,false)&0xff);}}
    asm volatile("s_waitcnt lgkmcnt(0)":::"memory");
    #pragma unroll
    for(int i=0;i<2;++i){const int row=i*16+(lane>>2),ch=lane&3; const u32x4 v=*(const u32x4*)(stg+row*64+ch*16); ATTN_STORE16(Ow+(long)row*DM+ch*16,v);} }
  asm volatile("s_waitcnt lgkmcnt(0)\n\ts_barrier":::"memory");
  #undef DMA_K
  #undef DMA_V
  #undef CMASK
  #undef START
  #undef RESC
  #undef ROT
}
constexpr int ATTN_LDS_BYTES=LDS_BYTES;
struct AttnTensors { const bf16* Q; const bf16* K; const bf16* V; bf16* O; };
struct AttnUnit { int bh; int qb; };
struct GqaOrder {
  int vcu, G;
  __device__ __forceinline__ GqaOrder(int grid,int block):vcu((grid%8==0)?(block%8)*(grid/8)+block/8:block),G(grid){}
  __device__ __forceinline__ bool next(int i,AttnUnit&u)const{ const int U=i*G+vcu; if(U>=BATCH*NHEAD*NQB)return false; const int pr=U>>6, idx=U&63; u.bh=(pr>>2)*NHEAD+(pr&3)*4+(idx>>4); u.qb=idx&15; return true; }
  __device__ __forceinline__ void a_ready(const AttnUnit&)const{}
  __device__ __forceinline__ void done(const AttnUnit&)const{}
};
template<class Sched,int THRL=8> __device__ __forceinline__ void attn_phase(char*lds,const AttnTensors&T,const Sched&S,const int tid,const float m0){
  AttnUnit u;
  for(int i=0;S.next(i,u);++i){ S.a_ready(u); attn_unit<THRL>(u.bh/NHEAD,u.bh%NHEAD,u.qb,T.Q,T.K,T.V,T.O,lds,tid,m0); S.done(u); }
}
template<int THRL=8,class PFn> __device__ __forceinline__ void attn_phase_dyn(char*lds,const AttnTensors&T,const int tid,const float m0,unsigned*ctr,volatile __attribute__((address_space(3))) unsigned*bw,const int xcd,const int np,PFn pf){
  const int total=256+np;
  #pragma unroll 1
  for(int qo=0;qo<8;++qo){ const int qx=(xcd+qo)&7; unsigned*c=ctr+qx*32;
    unsigned nextp=0; if(tid==0)nextp=__hip_atomic_fetch_add(c,1u,__ATOMIC_RELAXED,__HIP_MEMORY_SCOPE_AGENT);
    #pragma unroll 1
    for(;;){
      __syncthreads(); if(tid==0)*bw=nextp; __syncthreads();
      const int p=__builtin_amdgcn_readfirstlane((int)*bw);
      if(p>=total)break;
      if(tid==0)nextp=__hip_atomic_fetch_add(c,1u,__ATOMIC_RELAXED,__HIP_MEMORY_SCOPE_AGENT);
      int a=p,k=-1;
      if(np){ if(p>=416){k=160+(p-416);} else { const int g=p/13,q=p-13*g;
          const int pc=(q>2)+(q>5)+(q>7)+(q>10)+(q>12);
          if(q==2||q==5||q==7||q==10||q==12){k=5*g+(q==2?0:q==5?1:q==7?2:q==10?3:4);} else a=8*g+(q-pc); } }
      if(k>=0){ pf(qx*np+k); }
      else{ const int U=(a>>5)*256+32*qx+(a&31), pr=U>>6, idx=U&63, bh=(pr>>2)*NHEAD+(pr&3)*4+(idx>>4), qb=idx&15;
        attn_unit<THRL>(bh/NHEAD,bh%NHEAD,qb,T.Q,T.K,T.V,T.O,lds,tid,m0); }
    }
  }
}
#undef SBAR
#undef WAIT_BAR
}

constexpr int T = 32768, D = 1024, SEQ = 4096, NLAYER = 4, NE = 32;
constexpr float LN_EPS = 1e-5f, QK_EPS = 1e-6f;
constexpr float DN_ALPHA = 1.681792830507429f;
constexpr float WGU_SCALE = 64.0f, WDN_SCALE = 128.0f;
constexpr int WGU_E8M0 = 0x79797979, WDN_E8M0 = 0x78787878;

constexpr size_t MiB = 1u << 20;
constexpr size_t WS_CTL = 0, CTL_ZERO_BYTES = 128 * 1024;
constexpr size_t WS_ROPE = 1 * MiB;
constexpr size_t WS_BGU = 2 * MiB;
constexpr size_t WS_WS = 3 * MiB;
constexpr size_t WS_STATS = 4 * MiB;
constexpr size_t WS_GATE = 5 * MiB;
constexpr size_t WS_LIST = 6 * MiB;
constexpr size_t WS_GLIST = 10 * MiB;
constexpr size_t WS_WQKV = 16 * MiB, WS_WO = 22 * MiB, WS_GIN = 26 * MiB, WS_GOUT = 34 * MiB, WS_CIN = 38 * MiB, WS_COUT = 44 * MiB;
constexpr size_t WS_WGU = 64 * MiB;
constexpr size_t WS_WDN = 320 * MiB;
constexpr size_t WS_XB = 448 * MiB;
constexpr size_t WS_X8 = 512 * MiB;
constexpr size_t WS_HB = 544 * MiB;
constexpr size_t WS_MIX = 608 * MiB;
constexpr size_t WS_HM = 992 * MiB;
constexpr size_t WS_Y = 1136 * MiB;
constexpr size_t WS_END = 1393 * MiB;
constexpr int CW_BAR = 4096;
constexpr int CW_RDY = 26624;
constexpr int CW_QUE = 24576;
constexpr int CW_CNT = 16384;

constexpr int RING_OFF = 0, RING_BYTES = 131072;
constexpr int LDSCTL_OFF = 139264;
constexpr int MISC_OFF = LDSCTL_OFF;
constexpr int MOE_OFF = LDSCTL_OFF + 256;
constexpr int SEL_OFF = LDSCTL_OFF + 1024;
constexpr int LDS_BYTES = 147456;

#define GAS __attribute__((address_space(1)))
#define LAS __attribute__((address_space(3)))
typedef unsigned short bf16;
typedef unsigned v4u __attribute__((ext_vector_type(4)));
typedef unsigned v2u __attribute__((ext_vector_type(2)));
typedef float f32x4 __attribute__((ext_vector_type(4)));
typedef float f32x2v __attribute__((ext_vector_type(2)));
typedef GAS unsigned char* gptr;
#define LDS_WAIT() asm volatile("s_waitcnt lgkmcnt(0)" ::: "memory")
#define VM_WAIT() asm volatile("s_waitcnt vmcnt(0)" ::: "memory")
__device__ __forceinline__ unsigned f2bf(float f) { unsigned u = __builtin_bit_cast(unsigned, f); return (u + 0x7fffu + ((u >> 16) & 1u)) >> 16; }
__device__ __forceinline__ unsigned pk2(float lo, float hi) { return f2bf(lo) | (f2bf(hi) << 16); }
__device__ __forceinline__ float bflo(unsigned w) { return __builtin_bit_cast(float, w << 16); }
__device__ __forceinline__ float bfhi(unsigned w) { return __builtin_bit_cast(float, w & 0xffff0000u); }
__device__ __forceinline__ unsigned pk4f8(float a, float b, float c, float d) { int w = 0; w = __builtin_amdgcn_cvt_pk_fp8_f32(a, b, w, false); w = __builtin_amdgcn_cvt_pk_fp8_f32(c, d, w, true); return (unsigned)w; }
__device__ __forceinline__ void unpack8(const v4u w, float (&x)[8]) { x[0] = bflo(w.x); x[1] = bfhi(w.x); x[2] = bflo(w.y); x[3] = bfhi(w.y); x[4] = bflo(w.z); x[5] = bfhi(w.z); x[6] = bflo(w.w); x[7] = bfhi(w.w); }
__device__ __forceinline__ int uni(int v) { return __builtin_amdgcn_readfirstlane(v); }
__device__ __forceinline__ gptr uni(gptr p) { const unsigned long long v = (unsigned long long)p; const unsigned lo = __builtin_amdgcn_readfirstlane((unsigned)v), hi = __builtin_amdgcn_readfirstlane((unsigned)(v >> 32)); return (gptr)(((unsigned long long)hi << 32) | lo); }
#define UNIP(type, p) ((type)uni((gptr)(p)))

#define XB_TMO      128
#define XB_XCNT(j)  (256  + 64 * (j))
#define XB_XSUB(j)  (1280 + 64 * (j))
#define XB_XGEN(j)  (2304 + 64 * (j))
#define XB_TOP      3328
#define XB_TOPGEN   3392
#define XCD_BAR_WORDS 3456
#define XB_SPIN_CAP (1u << 18)

__device__ __forceinline__ unsigned xb_ld(unsigned* p)              { return __hip_atomic_load(p, __ATOMIC_RELAXED, __HIP_MEMORY_SCOPE_AGENT); }
__device__ __forceinline__ unsigned xb_add(unsigned* p, unsigned v) { return __hip_atomic_fetch_add(p, v, __ATOMIC_RELAXED, __HIP_MEMORY_SCOPE_AGENT); }
__device__ __forceinline__ unsigned xb_xcc_id() { return (unsigned)__builtin_amdgcn_s_getreg((3 << 11) | 20) & 0xFu; }
#define XB_SPIN(cond, bar) do { unsigned _sp = 0; while (cond) { __builtin_amdgcn_s_sleep(1); \
    if ((++_sp & 255u) == 0u) { if (xb_ld(&(bar)[XB_TMO])) break; if (_sp > XB_SPIN_CAP) { atomicAdd(&(bar)[XB_TMO], 1u); break; } } } } while (0)

struct XcdBarrier {
    unsigned* bar; unsigned x; int wave;
    volatile LAS unsigned* st;
};

__device__ __forceinline__ XcdBarrier xcd_barrier_post(unsigned* bar, volatile LAS unsigned* st) {
    XcdBarrier b; b.bar = bar; b.x = xb_xcc_id(); b.st = st;
    if (threadIdx.x == 0) st[2] = xb_add(&bar[XB_XCNT(b.x)], 1u);
    return b;
}
__device__ __forceinline__ void xcd_barrier_complete(unsigned* bar, unsigned x, unsigned& nloc, unsigned& nx, unsigned& pre) {
    const unsigned G = gridDim.x * gridDim.y * gridDim.z;
    unsigned sum, cnt, mine, below, sp = 0u;
    for (;;) {
        sum = 0u; cnt = 0u; mine = 0u; below = 0u;
#pragma unroll
        for (unsigned j = 0; j < 16; ++j) { const unsigned c = xb_ld(&bar[XB_XCNT(j)]); sum += c; cnt += (c > 0u) ? 1u : 0u; mine = (j == x) ? c : mine; below += (j < x) ? c : 0u; }
        if (sum == G) break;
        __builtin_amdgcn_s_sleep(1);
        if ((++sp & 255u) == 0u) { if (xb_ld(&bar[XB_TMO])) break; if (sp > XB_SPIN_CAP) { atomicAdd(&bar[XB_TMO], 1u); break; } }
    }
    nloc = mine > 0u ? mine : 1u; nx = cnt > 0u ? cnt : 1u; pre = below;
}

__device__ __forceinline__ void xcd_barrier(const XcdBarrier& b) {
    asm volatile("s_waitcnt vmcnt(0)" ::: "memory");
    __syncthreads();
    int xb_lane_; asm volatile("v_mbcnt_lo_u32_b32 %0, -1, 0\n\tv_mbcnt_hi_u32_b32 %0, -1, %0" : "=v"(xb_lane_));
    if (b.wave == 0 && xb_lane_ == 0) {
        unsigned* bar = b.bar;
        __builtin_amdgcn_s_waitcnt(0);
        unsigned nloc = b.st[0], nx = b.st[1];
        if (nloc == 0u) { unsigned pre_; xcd_barrier_complete(bar, b.x, nloc, nx, pre_); b.st[0] = nloc; b.st[1] = nx; b.st[3] = pre_; }
        const unsigned old = xb_add(&bar[XB_XSUB(b.x)], 1u);
        const unsigned gen = old / nloc;
        if (old + 1u == (gen + 1u) * nloc) {
            __builtin_amdgcn_fence(__ATOMIC_RELEASE, "agent");
            asm volatile("s_waitcnt vmcnt(0)" ::: "memory");
            const unsigned og = xb_add(&bar[XB_TOP], 1u);
            const unsigned tg = og / nx;
            if (og + 1u == (tg + 1u) * nx) xb_add(&bar[XB_TOPGEN], 1u);
            else XB_SPIN(xb_ld(&bar[XB_TOPGEN]) == tg, bar);
            __builtin_amdgcn_fence(__ATOMIC_ACQUIRE, "agent");
            xb_add(&bar[XB_XGEN(b.x)], 1u);
            asm volatile("s_waitcnt vmcnt(0)" ::: "memory");
        } else {
            XB_SPIN(xb_ld(&bar[XB_XGEN(b.x)]) == gen, bar);
            __builtin_amdgcn_fence(__ATOMIC_ACQUIRE, "agent");
            asm volatile("s_waitcnt vmcnt(0)" ::: "memory");
        }
    }
    __syncthreads();
}


__device__ __forceinline__ float wave_sum(float v) {
#pragma unroll
    for (int o = 1; o < 64; o <<= 1) v += __shfl_xor(v, o);
    return v;
}
struct TC { int lane, wave, G, vcu; };
__device__ __forceinline__ TC mk_tc(int wave) { TC c; int lane; asm volatile("v_mbcnt_lo_u32_b32 %0, -1, 0\n\tv_mbcnt_hi_u32_b32 %0, -1, %0" : "=v"(lane)); c.lane = lane; c.wave = wave; c.G = gridDim.x; const int bx = blockIdx.x; c.vcu = (c.G % 8 == 0) ? (bx % 8) * (c.G / 8) + bx / 8 : bx; return c; }
#define TC_UNPACK() extern __shared__ __attribute__((aligned(16))) unsigned char lds_raw[]; LAS unsigned char* const lds = (LAS unsigned char*)lds_raw; (void)lds; \
    const int lane = c_.lane, wave = uni(c_.wave), G = uni(c_.G), vcu = uni(c_.vcu), tid = wave * 64 + lane, gw = vcu * 8 + wave, NGW = G * 8; (void)tid; (void)gw; (void)NGW

__device__ __forceinline__ void sincos_d(double a, float& c, float& s) {
    const double k = __builtin_rint(a * 0.63661977236758134); const double r = a - k * 1.5707963267948966192; const double r2 = r * r;
    const double sn = r * (1.0 + r2 * (-1.0 / 6 + r2 * (1.0 / 120 + r2 * (-1.0 / 5040 + r2 * (1.0 / 362880 + r2 * (-1.0 / 39916800 + r2 * (1.0 / 6227020800.0)))))));
    const double cn = 1.0 + r2 * (-0.5 + r2 * (1.0 / 24 + r2 * (-1.0 / 720 + r2 * (1.0 / 40320 + r2 * (-1.0 / 3628800 + r2 * (1.0 / 479001600 + r2 * (-1.0 / 87178291200.0)))))));
    const int q = ((int)k) & 3;
    const double sv = (q == 0) ? sn : (q == 1) ? cn : (q == 2) ? -sn : -cn;
    const double cv = (q == 0) ? cn : (q == 1) ? -sn : (q == 2) ? -cn : sn;
    c = (float)cv; s = (float)sv;
}
template <int MODE, bool B16, bool NT = false> __device__ __forceinline__ void p0_item(const GAS float* W, int K, int N, gptr WT, float scale, LAS float* scr, int item, int lane) {
    const int nblk = N / 64, kb = item / nblk, nb = item % nblk, k0 = 64 * kb, n0 = 64 * nb;
    const int lr = lane >> 4, lc = (lane & 15) * 4;
    if constexpr (B16) { f32x4 vv[16];
#pragma unroll
        for (int i = 0; i < 16; ++i) { const GAS f32x4* p_ = (const GAS f32x4*)(W + (size_t)(k0 + 4 * i + lr) * N + n0 + lc); vv[i] = NT ? __builtin_nontemporal_load(p_) : *p_; }
#pragma unroll
        for (int i = 0; i < 16; ++i) { const int kk = 4 * i + lr; scr[kk * 65 + lc] = vv[i].x; scr[kk * 65 + lc + 1] = vv[i].y; scr[kk * 65 + lc + 2] = vv[i].z; scr[kk * 65 + lc + 3] = vv[i].w; }
    } else {
#pragma unroll 4
        for (int i = 0; i < 16; ++i) { const int kk = 4 * i + lr; const f32x4 v = *(const GAS f32x4*)(W + (size_t)(k0 + kk) * N + n0 + lc);
            scr[kk * 65 + lc] = v.x; scr[kk * 65 + lc + 1] = v.y; scr[kk * 65 + lc + 2] = v.z; scr[kk * 65 + lc + 3] = v.w; } }
    LDS_WAIT(); asm volatile("" ::: "memory");
    if (MODE == 0) {
        const int c = lane & 7;
#pragma unroll
        for (int j = 0; j < 8; ++j) { const int nl = (lane >> 3) + 8 * j; const LAS float* s = scr + (8 * c) * 65 + nl;
            v4u o; o.x = pk2(s[0 * 65], s[1 * 65]); o.y = pk2(s[2 * 65], s[3 * 65]); o.z = pk2(s[4 * 65], s[5 * 65]); o.w = pk2(s[6 * 65], s[7 * 65]);
            *(GAS v4u*)(WT + ((size_t)(n0 + nl) * K + k0 + 8 * c) * 2) = o; }
    } else {
        const int c = lane & 3;
#pragma unroll
        for (int j = 0; j < 4; ++j) { const int nl = (lane >> 2) + 16 * j; const LAS float* s = scr + (16 * c) * 65 + nl;
            v4u o; o.x = pk4f8(s[0 * 65] * scale, s[1 * 65] * scale, s[2 * 65] * scale, s[3 * 65] * scale); o.y = pk4f8(s[4 * 65] * scale, s[5 * 65] * scale, s[6 * 65] * scale, s[7 * 65] * scale);
            o.z = pk4f8(s[8 * 65] * scale, s[9 * 65] * scale, s[10 * 65] * scale, s[11 * 65] * scale); o.w = pk4f8(s[12 * 65] * scale, s[13 * 65] * scale, s[14 * 65] * scale, s[15 * 65] * scale);
            const int n = n0 + nl; int row = n; if (MODE == 1) { const int jj = n >> 1; row = (jj >> 7) * 256 + (n & 1) * 128 + (jj & 127); }
            GAS v4u* q_ = (GAS v4u*)(WT + (size_t)row * K + k0 + 16 * c); if (NT) __builtin_nontemporal_store(o, q_); else *q_ = o; }
    }
    LDS_WAIT(); asm volatile("" ::: "memory");
}
template <bool NT> __device__ __forceinline__ void p0_load(f32x4 (&vv)[16], const GAS float* W, int N, int item, int lane) {
    const int nblk = N / 64, kb = item / nblk, nb = item % nblk, k0 = 64 * kb, n0 = 64 * nb; const int lr = lane >> 4, lc = (lane & 15) * 4;
#pragma unroll
    for (int i = 0; i < 16; ++i) { const GAS f32x4* p_ = (const GAS f32x4*)(W + (size_t)(k0 + 4 * i + lr) * N + n0 + lc); vv[i] = NT ? __builtin_nontemporal_load(p_) : *p_; }
}
__device__ __forceinline__ void p0_put(const f32x4 (&vv)[16], LAS float* scr, int lane) {
    const int lr = lane >> 4, lc = (lane & 15) * 4;
#pragma unroll
    for (int i = 0; i < 16; ++i) { const int kk = 4 * i + lr; scr[kk * 65 + lc] = vv[i].x; scr[kk * 65 + lc + 1] = vv[i].y; scr[kk * 65 + lc + 2] = vv[i].z; scr[kk * 65 + lc + 3] = vv[i].w; }
}
template <int MODE, bool NT> __device__ __forceinline__ void p0_out(const LAS float* scr, int K, int N, gptr WT, float scale, int item, int lane) {
    const int nblk = N / 64, kb = item / nblk, nb = item % nblk, k0 = 64 * kb, n0 = 64 * nb;
    const int c = lane & 3;
#pragma unroll
    for (int j = 0; j < 4; ++j) { const int nl = (lane >> 2) + 16 * j; const LAS float* s = scr + (16 * c) * 65 + nl;
        v4u o; o.x = pk4f8(s[0 * 65] * scale, s[1 * 65] * scale, s[2 * 65] * scale, s[3 * 65] * scale); o.y = pk4f8(s[4 * 65] * scale, s[5 * 65] * scale, s[6 * 65] * scale, s[7 * 65] * scale);
        o.z = pk4f8(s[8 * 65] * scale, s[9 * 65] * scale, s[10 * 65] * scale, s[11 * 65] * scale); o.w = pk4f8(s[12 * 65] * scale, s[13 * 65] * scale, s[14 * 65] * scale, s[15 * 65] * scale);
        const int n = n0 + nl; int row = n; if (MODE == 1) { const int jj = n >> 1; row = (jj >> 7) * 256 + (n & 1) * 128 + (jj & 127); }
        GAS v4u* q_ = (GAS v4u*)(WT + (size_t)row * K + k0 + 16 * c); if (NT) __builtin_nontemporal_store(o, q_); else *q_ = o; }
}
#define P0_JOB(MODE_, srcp, K_, N_, NMAT_, DST_, ES_, SC_) do { constexpr int per = ((K_) / 64) * ((N_) / 64), n_items = per * (NMAT_); \
        _Pragma("unroll 1") for (int it = gw; it < n_items; it += NGW) { const int mat = it / per, r = it % per; \
            p0_item<MODE_, ((NMAT_) > 8)>((srcp) + (size_t)mat * (K_) * (N_), (K_), (N_), ws + (DST_) + (size_t)mat * (K_) * (N_) * (ES_), (SC_), scr, r, lane); } } while (0)
__device__ __noinline__ void p0_experts(TC c_, gptr ws_, const GAS float* wgu_, const GAS float* wdn_) {
    TC_UNPACK(); gptr ws = uni(ws_); const GAS float* wgu = UNIP(const GAS float*, wgu_); const GAS float* wdn = UNIP(const GAS float*, wdn_);
    LAS float* scr = (LAS float*)(lds + RING_OFF + wave * 16640);
    P0_JOB(1, wgu, 1024, 2048, 128, WS_WGU, 1, WGU_SCALE);
    P0_JOB(2, wdn, 1024, 1024, 128, WS_WDN, 1, WDN_SCALE);
}
#ifndef P0_NT
#define P0_NT true
#endif
__device__ __noinline__ void p0_chunk(TC c_, gptr ws_, const GAS float* wgu_, const GAS float* wdn_, int chunk_) {
    TC_UNPACK(); gptr ws = uni(ws_); const GAS float* wgu = UNIP(const GAS float*, wgu_); const GAS float* wdn = UNIP(const GAS float*, wdn_); const int chunk = uni(chunk_);
    LAS float* scr = (LAS float*)(lds + RING_OFF + wave * 16640);
    f32x4 vv[16];
    if (chunk < 1024) { const int it0 = chunk * 64 + wave;
        p0_load<P0_NT>(vv, wgu + (size_t)(it0 >> 9) * 1024 * 2048, 2048, it0 & 511, lane);
#pragma unroll 1
        for (int j = 0; j < 8; ++j) { const int it = it0 + j * 8, itn = it + 8;
            p0_put(vv, scr, lane);
            if (j < 7) p0_load<P0_NT>(vv, wgu + (size_t)(itn >> 9) * 1024 * 2048, 2048, itn & 511, lane);
            LDS_WAIT(); asm volatile("" ::: "memory");
            p0_out<1, P0_NT>(scr, 1024, 2048, ws + WS_WGU + (size_t)(it >> 9) * 1024 * 2048, WGU_SCALE, it & 511, lane);
            LDS_WAIT(); asm volatile("" ::: "memory"); }
    } else { const int it0 = (chunk - 1024) * 64 + wave;
        p0_load<P0_NT>(vv, wdn + (size_t)(it0 >> 8) * 1024 * 1024, 1024, it0 & 255, lane);
#pragma unroll 1
        for (int j = 0; j < 8; ++j) { const int it = it0 + j * 8, itn = it + 8;
            p0_put(vv, scr, lane);
            if (j < 7) p0_load<P0_NT>(vv, wdn + (size_t)(itn >> 8) * 1024 * 1024, 1024, itn & 255, lane);
            LDS_WAIT(); asm volatile("" ::: "memory");
            p0_out<2, P0_NT>(scr, 1024, 1024, ws + WS_WDN + (size_t)(it >> 8) * 1024 * 1024, WDN_SCALE, it & 255, lane);
            LDS_WAIT(); asm volatile("" ::: "memory"); }
    }
}
__device__ __noinline__ void p0_dense(TC c_, gptr ws_, const GAS float* wqkv_, const GAS float* wo_, const GAS float* gin_, const GAS float* gout_, const GAS float* cin_, const GAS float* cout_) {
    TC_UNPACK(); gptr ws = uni(ws_);
    const GAS float* wqkv = UNIP(const GAS float*, wqkv_); const GAS float* wo = UNIP(const GAS float*, wo_); const GAS float* gin = UNIP(const GAS float*, gin_);
    const GAS float* gout = UNIP(const GAS float*, gout_); const GAS float* cin = UNIP(const GAS float*, cin_); const GAS float* cout = UNIP(const GAS float*, cout_);
    LAS float* scr = (LAS float*)(lds + RING_OFF + wave * 16640);
    P0_JOB(2, wqkv, 1024, 1536, 2, WS_WQKV, 1, WGU_SCALE);
    P0_JOB(2, wo, 1024, 1024, 2, WS_WO, 1, WDN_SCALE);
    P0_JOB(2, gin, 1024, 4096, 1, WS_GIN, 1, WGU_SCALE);
    P0_JOB(2, gout, 2048, 1024, 1, WS_GOUT, 1, WDN_SCALE);
    P0_JOB(0, cin, 1024, 3072, 1, WS_CIN, 2, 1.0f);
    P0_JOB(2, cout, 1024, 1024, 1, WS_COUT, 1, WDN_SCALE);
}
#undef P0_JOB
__device__ __noinline__ void p0_misc(TC c_, gptr ws_, const GAS float* x_, const GAS float* wsp_, const GAS float* bgu_) {
    TC_UNPACK(); gptr ws = uni(ws_); const GAS float* x = UNIP(const GAS float*, x_); const GAS float* w = UNIP(const GAS float*, wsp_); const GAS float* b = UNIP(const GAS float*, bgu_);
    const int gt = gw * 64 + lane, NT_ = NGW * 64;
    { GAS bf16* o = (GAS bf16*)(ws + WS_WS); for (int i = gt; i < 8 * 128 * 128; i += NT_) o[i] = (bf16)f2bf(w[i]); }
    { GAS float* o = (GAS float*)(ws + WS_BGU); for (int i = gt; i < 4 * 32 * 2048; i += NT_) { const int le = i >> 11, cc = i & 2047, pn = cc >> 8, bj = (cc >> 7) & 1, ii = cc & 127; o[i] = b[(size_t)le * 2048 + 2 * (pn * 128 + ii) + bj]; } }
    { GAS f32x2v* o = (GAS f32x2v*)(ws + WS_ROPE); for (int i = gt; i < 4096 * 32; i += NT_) { const int s = i >> 5, p = i & 31; const double pos = (double)((p < 16) ? (s >> 6) : (s & 63));
        const int pi = p & 15, q4 = pi & 3, d4 = pi >> 2;
        const double b4 = q4 == 0 ? 1.0 : q4 == 1 ? 0.5623413251903491 : q4 == 2 ? 0.31622776601683794 : 0.1778279410038923;
        const double sc = d4 == 0 ? 1.0 : d4 == 1 ? 0.1 : d4 == 2 ? 0.01 : 0.001;
        float cv, sv; sincos_d(pos * (b4 * sc), cv, sv); o[i] = (f32x2v){cv, sv}; } }
    { GAS v2u* xb = (GAS v2u*)(ws + WS_XB);
      GAS unsigned* x8 = (GAS unsigned*)(ws + WS_X8);
      for (size_t i0 = (size_t)gt; i0 < (size_t)T * D / 4; i0 += (size_t)8 * NT_) { f32x4 v[8];
#pragma unroll
          for (int q = 0; q < 8; ++q) { const size_t i = i0 + (size_t)q * NT_; v[q] = (i < (size_t)T * D / 4) ? ((const GAS f32x4*)x)[i] : (f32x4){0.f, 0.f, 0.f, 0.f}; }
#pragma unroll
          for (int q = 0; q < 8; ++q) { const size_t i = i0 + (size_t)q * NT_; if (i < (size_t)T * D / 4) { v2u o; o.x = pk2(v[q].x, v[q].y); o.y = pk2(v[q].z, v[q].w); xb[i] = o; x8[i] = pk4f8(v[q].x, v[q].y, v[q].z, v[q].w); } } } }
}

template <int CTRL, int ROWMASK = 0xF, int BANKMASK = 0xF> __device__ __forceinline__ float dppf(float old, float src) {
    return __builtin_bit_cast(float, __builtin_amdgcn_update_dpp(__builtin_bit_cast(int, old), __builtin_bit_cast(int, src), CTRL, ROWMASK, BANKMASK, false)); }
template <int CTRL, int ROWMASK = 0xF, int BANKMASK = 0xF> __device__ __forceinline__ unsigned dppu(unsigned old, unsigned src) {
    return (unsigned)__builtin_amdgcn_update_dpp((int)old, (int)src, CTRL, ROWMASK, BANKMASK, false); }
__device__ __forceinline__ float wsum(float v) {
    v += dppf<0xB1>(0.f, v); v += dppf<0x4E>(0.f, v); v += dppf<0x141>(0.f, v); v += dppf<0x140>(0.f, v);
    v += dppf<0x142, 0xA>(0.f, v); v += dppf<0x143, 0xC>(0.f, v);
    return __builtin_bit_cast(float, __builtin_amdgcn_readlane(__builtin_bit_cast(int, v), 63));
}
__device__ __forceinline__ unsigned wmaxu(unsigned v) {
    v = max(v, dppu<0xB1>(0u, v)); v = max(v, dppu<0x4E>(0u, v)); v = max(v, dppu<0x141>(0u, v)); v = max(v, dppu<0x140>(0u, v));
    v = max(v, dppu<0x142, 0xA>(0u, v)); v = max(v, dppu<0x143, 0xC>(0u, v));
    return (unsigned)__builtin_amdgcn_readlane((int)v, 63);
}
__device__ __forceinline__ void ld_bf8(const GAS bf16* row, int lane, int j, float (&x)[8]) { const v4u w = ((const GAS v4u*)row)[lane + 64 * j]; x[0] = bflo(w.x); x[1] = bfhi(w.x); x[2] = bflo(w.y); x[3] = bfhi(w.y); x[4] = bflo(w.z); x[5] = bfhi(w.z); x[6] = bflo(w.w); x[7] = bfhi(w.w); }
__device__ __forceinline__ void ln16(float (&v)[16], const float (&g)[16], const float (&b)[16]) {
    float s = 0.f;
#pragma unroll
    for (int i = 0; i < 16; ++i) s += v[i];
    const float mean = wsum(s) * (1.f / D); float s2 = 0.f;
#pragma unroll
    for (int i = 0; i < 16; ++i) { v[i] -= mean; s2 += v[i] * v[i]; }
    const float rstd = 1.f / sqrtf(wsum(s2) * (1.f / D) + LN_EPS);
#pragma unroll
    for (int i = 0; i < 16; ++i) v[i] = v[i] * rstd * g[i] + b[i];
}
__device__ __forceinline__ void ln16_lds(float (&v)[16], const LAS float* gb, int lane) {
    float s = 0.f;
#pragma unroll
    for (int i = 0; i < 16; ++i) s += v[i];
    const float mean = wsum(s) * (1.f / D); float s2 = 0.f;
#pragma unroll
    for (int i = 0; i < 16; ++i) { v[i] -= mean; s2 += v[i] * v[i]; }
    const float rstd = 1.f / sqrtf(wsum(s2) * (1.f / D) + LN_EPS);
#pragma unroll
    for (int j = 0; j < 2; ++j)
#pragma unroll
        for (int h = 0; h < 2; ++h) { const f32x4 gg = *(const LAS f32x4*)(gb + 8 * lane + 512 * j + 4 * h), bb = *(const LAS f32x4*)(gb + 1024 + 8 * lane + 512 * j + 4 * h);
#pragma unroll
            for (int i = 0; i < 4; ++i) v[8 * j + 4 * h + i] = v[8 * j + 4 * h + i] * rstd * gg[i] + bb[i]; }
}
__device__ __forceinline__ float logit_reduce16(const float (&a)[16], int lane) {
    float r8[8], r4[4], r2[2];
#pragma unroll
    for (int i = 0; i < 8; ++i) { const auto rr = __builtin_amdgcn_permlane16_swap(__float_as_uint(a[i]), __float_as_uint(a[8 + i]), false, false); r8[i] = __uint_as_float(rr[0]) + __uint_as_float(rr[1]); }
    { const bool hb = lane & 8;
#pragma unroll
      for (int i = 0; i < 4; ++i) { const float keep = hb ? r8[4 + i] : r8[i], send = hb ? r8[i] : r8[4 + i]; r4[i] = keep + dppf<0x128>(0.f, send); } }
    { const bool hb = lane & 4;
#pragma unroll
      for (int i = 0; i < 2; ++i) { const float keep = hb ? r4[2 + i] : r4[i], send = hb ? r4[i] : r4[2 + i]; float t = dppf<0x104, 0xF, 0x5>(0.f, send); t = dppf<0x114, 0xF, 0xA>(t, send); r2[i] = keep + t; } }
    float r1; { const bool hb = lane & 2; const float keep = hb ? r2[1] : r2[0], send = hb ? r2[0] : r2[1]; r1 = keep + dppf<0x4E>(0.f, send); }
    r1 += dppf<0xB1>(0.f, r1);
    const auto rr = __builtin_amdgcn_permlane32_swap(__float_as_uint(r1), __float_as_uint(r1), false, false);
    return __uint_as_float(rr[0]) + __uint_as_float(rr[1]);
}
__device__ __forceinline__ unsigned logit_key(float logit, int e) { const unsigned fb = __float_as_uint(logit); const unsigned ord = (fb & 0x80000000u) ? ~fb : (fb | 0x80000000u); return (ord & ~31u) | (unsigned)(31 - e); }
__device__ __forceinline__ void route_row(float la, float lb, int lane, int rowl, LAS int* lcnt, LAS int* sel_e, LAS float* sel_g) {
    const int el = (lane >> 1) & 15;
    unsigned ka = logit_key(la, el), kb = logit_key(lb, 16 + el);
    unsigned tk[4];
#pragma unroll
    for (int k = 0; k < 4; ++k) { tk[k] = wmaxu(max(ka, kb)); ka = (ka == tk[k]) ? 0u : ka; kb = (kb == tk[k]) ? 0u : kb; }
    float tv[4]; int te[4];
#pragma unroll
    for (int k = 0; k < 4; ++k) { te[k] = 31 - (int)(tk[k] & 31u); const unsigned o = tk[k] & ~31u; tv[k] = __uint_as_float((o & 0x80000000u) ? (o & 0x7fffffffu) : ~o); }
    float p[4], s = 0.f;
#pragma unroll
    for (int k = 0; k < 4; ++k) { p[k] = __expf(tv[k] - tv[0]); s += p[k]; }
    const float inv = 1.0f / s;
    if (lane < 4) { const int ek = lane == 0 ? te[0] : lane == 1 ? te[1] : lane == 2 ? te[2] : te[3]; const float gk = (lane == 0 ? p[0] : lane == 1 ? p[1] : lane == 2 ? p[2] : p[3]) * inv;
        const int r = __hip_atomic_fetch_add(lcnt + ek, 1, __ATOMIC_RELAXED, __HIP_MEMORY_SCOPE_WORKGROUP); sel_e[rowl * 4 + lane] = ek | (r << 8); sel_g[rowl * 4 + lane] = gk; }
}
__device__ __forceinline__ void phase_ln_router(TC c_, gptr ws_, const GAS float* lg_, const GAS float* lb_, const GAS float* Wr_, const GAS float* br_, int layer_, int dry_) {
    TC_UNPACK(); gptr ws = uni(ws_); const int layer = uni(layer_); const int dry = uni(dry_);
    const GAS float* lg = UNIP(const GAS float*, lg_); const GAS float* lb = UNIP(const GAS float*, lb_); const GAS float* Wr = UNIP(const GAS float*, Wr_); const GAS float* br = UNIP(const GAS float*, br_);
    const GAS bf16* XB = (const GAS bf16*)(ws + WS_XB); GAS bf16* XBo = (GAS bf16*)(ws + (dry ? WS_HM : WS_XB)); const GAS bf16* HB = (const GAS bf16*)(ws + WS_HB); GAS v2u* X8 = (GAS v2u*)(ws + (dry ? WS_HM + 64 * MiB : WS_X8));
    GAS unsigned* gcnt = (GAS unsigned*)(ws + WS_CTL) + CW_CNT + layer * 32 + (dry ? 1024 : 0); GAS int* list = (GAS int*)(ws + (dry ? WS_Y : WS_LIST)); GAS float* glist = (GAS float*)(ws + (dry ? WS_Y + 8 * MiB : WS_GLIST));
    LAS int* lcnt = (LAS int*)(lds + MOE_OFF) + 65; LAS int* lbase = lcnt + 32;
    LAS int* sel_e = (LAS int*)(lds + SEL_OFF); LAS float* sel_g = (LAS float*)(lds + SEL_OFF + 2048);
    typedef short bf16x8 __attribute__((ext_vector_type(8)));
    constexpr int XPITCH = 2064, XLO = 16 * XPITCH, PP_OFF = 2 * XLO, PPITCH = 33, PP_ONE = 8 * 16 * PPITCH;
    LAS unsigned char* XS = lds + RING_OFF; LAS float* PP = (LAS float*)(lds + RING_OFF + PP_OFF);
    v4u bh[4][2], bl[4][2];
    { const int n = lane & 15, kq = lane >> 4;
#pragma unroll
      for (int ks = 0; ks < 4; ++ks)
#pragma unroll
          for (int nb = 0; nb < 2; ++nb) { float wv[8];
#pragma unroll
              for (int i = 0; i < 8; ++i) wv[i] = Wr[(size_t)(128 * wave + 32 * ks + 8 * kq + i) * 32 + 16 * nb + n];
              v4u h; h.x = pk2(wv[0], wv[1]); h.y = pk2(wv[2], wv[3]); h.z = pk2(wv[4], wv[5]); h.w = pk2(wv[6], wv[7]);
              v4u l; l.x = pk2(wv[0] - bflo(h.x), wv[1] - bfhi(h.x)); l.y = pk2(wv[2] - bflo(h.y), wv[3] - bfhi(h.y)); l.z = pk2(wv[4] - bflo(h.z), wv[5] - bfhi(h.z)); l.w = pk2(wv[6] - bflo(h.w), wv[7] - bfhi(h.w));
              bh[ks][nb] = h; bl[ks][nb] = l; } }
    const int el = (lane >> 1) & 15;
    const float bias_a = br[el], bias_b = br[16 + el];
    LAS float* gb = (LAS float*)(lds + RING_BYTES);
    { const f32x4 t = (tid < 256) ? ((const GAS f32x4*)lg)[tid] : ((const GAS f32x4*)lb)[tid - 256]; *(LAS f32x4*)(gb + 4 * tid) = t; }
    for (int rb = blockIdx.x; rb < T / 128; rb += G) {
        if (tid < 32) lcnt[tid] = 0;
        __syncthreads();
#pragma unroll 1
        for (int rr = 0; rr < 16; rr += 2) {
            const int rowl = wave * 16 + rr; const size_t row = (size_t)rb * 128 + rowl;
            float v0[16], v1[16];
#pragma unroll
            for (int j = 0; j < 2; ++j) { float x[8], h[8]; ld_bf8(XB + row * D, lane, j, x); ld_bf8(HB + row * D, lane, j, h);
#pragma unroll
                for (int i = 0; i < 8; ++i) v0[8 * j + i] = x[i] * DN_ALPHA + h[i];
                ld_bf8(XB + (row + 1) * D, lane, j, x); ld_bf8(HB + (row + 1) * D, lane, j, h);
#pragma unroll
                for (int i = 0; i < 8; ++i) v1[8 * j + i] = x[i] * DN_ALPHA + h[i]; }
            ln16_lds(v0, gb, lane); ln16_lds(v1, gb, lane);
#pragma unroll
            for (int j = 0; j < 2; ++j) {
                v4u o; o.x = pk2(v0[8 * j], v0[8 * j + 1]); o.y = pk2(v0[8 * j + 2], v0[8 * j + 3]); o.z = pk2(v0[8 * j + 4], v0[8 * j + 5]); o.w = pk2(v0[8 * j + 6], v0[8 * j + 7]);
                ((GAS v4u*)(XBo + row * D))[lane + 64 * j] = o;
                { v4u r; r.x = pk2(v0[8 * j] - bflo(o.x), v0[8 * j + 1] - bfhi(o.x)); r.y = pk2(v0[8 * j + 2] - bflo(o.y), v0[8 * j + 3] - bfhi(o.y)); r.z = pk2(v0[8 * j + 4] - bflo(o.z), v0[8 * j + 5] - bfhi(o.z)); r.w = pk2(v0[8 * j + 6] - bflo(o.w), v0[8 * j + 7] - bfhi(o.w));
                  LAS unsigned char* xp = XS + (2 * wave) * XPITCH + 2 * (8 * lane + 512 * j); *(LAS v4u*)xp = o; *(LAS v4u*)(xp + XLO) = r; }
                v2u q; q.x = pk4f8(v0[8 * j], v0[8 * j + 1], v0[8 * j + 2], v0[8 * j + 3]); q.y = pk4f8(v0[8 * j + 4], v0[8 * j + 5], v0[8 * j + 6], v0[8 * j + 7]); X8[row * (D / 8) + lane + 64 * j] = q;
                o.x = pk2(v1[8 * j], v1[8 * j + 1]); o.y = pk2(v1[8 * j + 2], v1[8 * j + 3]); o.z = pk2(v1[8 * j + 4], v1[8 * j + 5]); o.w = pk2(v1[8 * j + 6], v1[8 * j + 7]);
                ((GAS v4u*)(XBo + (row + 1) * D))[lane + 64 * j] = o;
                { v4u r; r.x = pk2(v1[8 * j] - bflo(o.x), v1[8 * j + 1] - bfhi(o.x)); r.y = pk2(v1[8 * j + 2] - bflo(o.y), v1[8 * j + 3] - bfhi(o.y)); r.z = pk2(v1[8 * j + 4] - bflo(o.z), v1[8 * j + 5] - bfhi(o.z)); r.w = pk2(v1[8 * j + 6] - bflo(o.w), v1[8 * j + 7] - bfhi(o.w));
                  LAS unsigned char* xp = XS + (2 * wave + 1) * XPITCH + 2 * (8 * lane + 512 * j); *(LAS v4u*)xp = o; *(LAS v4u*)(xp + XLO) = r; }
                q.x = pk4f8(v1[8 * j], v1[8 * j + 1], v1[8 * j + 2], v1[8 * j + 3]); q.y = pk4f8(v1[8 * j + 4], v1[8 * j + 5], v1[8 * j + 6], v1[8 * j + 7]); X8[(row + 1) * (D / 8) + lane + 64 * j] = q; }
            __syncthreads();
            LAS float* pp = PP + ((rr >> 1) & 1) * PP_ONE;
            { const int m = lane & 15, kq = lane >> 4;
              f32x4 acc[2] = {(f32x4){0.f, 0.f, 0.f, 0.f}, (f32x4){0.f, 0.f, 0.f, 0.f}};
#pragma unroll
              for (int ks = 0; ks < 4; ++ks) { const LAS unsigned char* ap = XS + m * XPITCH + 2 * (128 * wave + 32 * ks + 8 * kq);
                  const bf16x8 ah = __builtin_bit_cast(bf16x8, *(const LAS v4u*)ap), al = __builtin_bit_cast(bf16x8, *(const LAS v4u*)(ap + XLO));
#pragma unroll
                  for (int nb = 0; nb < 2; ++nb) { const bf16x8 wh = __builtin_bit_cast(bf16x8, bh[ks][nb]), wl = __builtin_bit_cast(bf16x8, bl[ks][nb]);
                      acc[nb] = __builtin_amdgcn_mfma_f32_16x16x32_bf16(ah, wh, acc[nb], 0, 0, 0);
                      acc[nb] = __builtin_amdgcn_mfma_f32_16x16x32_bf16(al, wh, acc[nb], 0, 0, 0);
                      acc[nb] = __builtin_amdgcn_mfma_f32_16x16x32_bf16(ah, wl, acc[nb], 0, 0, 0); } }
#pragma unroll
              for (int nb = 0; nb < 2; ++nb)
#pragma unroll
                  for (int i = 0; i < 4; ++i) pp[(wave * 16 + 4 * kq + i) * PPITCH + 16 * nb + m] = acc[nb][i]; }
            __syncthreads();
#pragma unroll
            for (int r2 = 0; r2 < 2; ++r2) { const int srow = 2 * wave + r2; float la = 0.f, lbv = 0.f;
#pragma unroll
                for (int w8 = 0; w8 < 8; ++w8) { la += pp[(w8 * 16 + srow) * PPITCH + el]; lbv += pp[(w8 * 16 + srow) * PPITCH + 16 + el]; }
                route_row(la + bias_a, lbv + bias_b, lane, rowl + r2, lcnt, sel_e, sel_g); }
        }
        __syncthreads();
        if (tid < 32) lbase[tid] = (int)__hip_atomic_fetch_add(gcnt + tid, (unsigned)lcnt[tid], __ATOMIC_RELAXED, __HIP_MEMORY_SCOPE_AGENT);
        __syncthreads();
        { const int se = sel_e[tid]; const int e = se & 255, r = se >> 8; const int a = (rb * 128 + (tid >> 2)) * 4 + (tid & 3);
          list[(size_t)e * T + lbase[e] + r] = a; glist[(size_t)e * T + lbase[e] + r] = sel_g[tid]; }
        __syncthreads();
    }
}
__device__ __noinline__ void phase_combine(TC c_, gptr ws_, const GAS float* lg_, const GAS float* lb_, GAS float* out_, int w8_) {
    TC_UNPACK(); gptr ws = uni(ws_); const int w8 = uni(w8_); GAS v2u* X8 = (GAS v2u*)(ws + WS_X8); const GAS float* lg = UNIP(const GAS float*, lg_); const GAS float* lb = UNIP(const GAS float*, lb_); GAS float* out = UNIP(GAS float*, out_);
    GAS bf16* XB = (GAS bf16*)(ws + WS_XB); const GAS unsigned char* Y = (const GAS unsigned char*)(ws + WS_Y);
    LAS float* gb = (LAS float*)(lds + RING_BYTES);
    { const f32x4 t = (tid < 256) ? ((const GAS f32x4*)lg)[tid] : ((const GAS f32x4*)lb)[tid - 256]; *(LAS f32x4*)(gb + 4 * tid) = t; }
    __syncthreads();
    v4u cx[2], nx[2]; v2u cy[4][2], ny[4][2];
    int row = gw;
    if (row < T) {
#pragma unroll
        for (int j = 0; j < 2; ++j) { cx[j] = ((const GAS v4u*)(XB + (size_t)row * D))[lane + 64 * j];
#pragma unroll
            for (int k = 0; k < 4; ++k) cy[k][j] = ((const GAS v2u*)(Y + ((size_t)row * 4 + k) * D))[lane + 64 * j]; } }
#pragma unroll 1
    for (; row < T; row += NGW) {
        const int nrow = row + NGW;
        if (nrow < T) {
#pragma unroll
            for (int j = 0; j < 2; ++j) { nx[j] = ((const GAS v4u*)(XB + (size_t)nrow * D))[lane + 64 * j];
#pragma unroll
                for (int k = 0; k < 4; ++k) ny[k][j] = ((const GAS v2u*)(Y + ((size_t)nrow * 4 + k) * D))[lane + 64 * j]; } }
        float v[16];
#pragma unroll
        for (int j = 0; j < 2; ++j) { float x[8]; unpack8(cx[j], x);
#pragma unroll
            for (int i = 0; i < 8; ++i) v[8 * j + i] = x[i] * DN_ALPHA;
#pragma unroll
            for (int k = 0; k < 4; ++k) { const f32x2v a0 = __builtin_amdgcn_cvt_pk_f32_fp8((int)cy[k][j].x, false), a1 = __builtin_amdgcn_cvt_pk_f32_fp8((int)cy[k][j].x, true), a2 = __builtin_amdgcn_cvt_pk_f32_fp8((int)cy[k][j].y, false), a3 = __builtin_amdgcn_cvt_pk_f32_fp8((int)cy[k][j].y, true);
                v[8 * j] += a0.x * 0.015625f; v[8 * j + 1] += a0.y * 0.015625f; v[8 * j + 2] += a1.x * 0.015625f; v[8 * j + 3] += a1.y * 0.015625f; v[8 * j + 4] += a2.x * 0.015625f; v[8 * j + 5] += a2.y * 0.015625f; v[8 * j + 6] += a3.x * 0.015625f; v[8 * j + 7] += a3.y * 0.015625f; } }
        ln16_lds(v, gb, lane);
        if (out) {
#pragma unroll
            for (int j = 0; j < 2; ++j) { ((GAS f32x4*)(out + (size_t)row * D))[2 * lane + 128 * j] = (f32x4){v[8 * j], v[8 * j + 1], v[8 * j + 2], v[8 * j + 3]};
                ((GAS f32x4*)(out + (size_t)row * D))[2 * lane + 128 * j + 1] = (f32x4){v[8 * j + 4], v[8 * j + 5], v[8 * j + 6], v[8 * j + 7]}; }
        } else {
#pragma unroll
            for (int j = 0; j < 2; ++j) { v4u o; o.x = pk2(v[8 * j], v[8 * j + 1]); o.y = pk2(v[8 * j + 2], v[8 * j + 3]); o.z = pk2(v[8 * j + 4], v[8 * j + 5]); o.w = pk2(v[8 * j + 6], v[8 * j + 7]);
                ((GAS v4u*)(XB + (size_t)row * D))[lane + 64 * j] = o;
                if (w8) { v2u q; q.x = pk4f8(v[8 * j], v[8 * j + 1], v[8 * j + 2], v[8 * j + 3]); q.y = pk4f8(v[8 * j + 4], v[8 * j + 5], v[8 * j + 6], v[8 * j + 7]); X8[(size_t)row * (D / 8) + lane + 64 * j] = q; } }
        }
#pragma unroll
        for (int j = 0; j < 2; ++j) { cx[j] = nx[j];
#pragma unroll
            for (int k = 0; k < 4; ++k) cy[k][j] = ny[k][j]; }
    }
}
__device__ __forceinline__ void rope_piece(GAS bf16* p, const GAS float* g8, const GAS f32x2v* cs4, float scale) {
    v4u w = *(GAS v4u*)p; float x[8] = {bflo(w.x), bfhi(w.x), bflo(w.y), bfhi(w.y), bflo(w.z), bfhi(w.z), bflo(w.w), bfhi(w.w)};
    float ss = 0.f;
#pragma unroll
    for (int i = 0; i < 8; ++i) ss += x[i] * x[i];
    ss += __shfl_xor(ss, 1); ss += __shfl_xor(ss, 2); ss += __shfl_xor(ss, 4);
    const float r = 1.0f / sqrtf(ss * (1.0f / 64.0f) + QK_EPS) ;
    const f32x4 g0 = ((const GAS f32x4*)g8)[0], g1 = ((const GAS f32x4*)g8)[1];
    const float gg[8] = {g0.x, g0.y, g0.z, g0.w, g1.x, g1.y, g1.z, g1.w};
    float y[8];
#pragma unroll
    for (int i = 0; i < 8; ++i) x[i] = x[i] * r * gg[i];
#pragma unroll
    for (int i = 0; i < 4; ++i) { const f32x2v cs = cs4[i]; y[2 * i] = (x[2 * i] * cs.x - x[2 * i + 1] * cs.y) * scale; y[2 * i + 1] = (x[2 * i] * cs.y + x[2 * i + 1] * cs.x) * scale; }
    w.x = pk2(y[0], y[1]); w.y = pk2(y[2], y[3]); w.z = pk2(y[4], y[5]); w.w = pk2(y[6], y[7]);
    *(GAS v4u*)p = w;
}
__device__ __noinline__ void phase_qk_rope(TC c_, gptr ws_, const GAS float* qg_, const GAS float* kg_) {
    TC_UNPACK(); gptr ws = uni(ws_); const GAS float* qg = UNIP(const GAS float*, qg_); const GAS float* kg = UNIP(const GAS float*, kg_);
    GAS bf16* Q = (GAS bf16*)(ws + WS_MIX); GAS bf16* Kb = (GAS bf16*)(ws + WS_MIX + 64 * MiB); const GAS f32x2v* rope = (const GAS f32x2v*)(ws + WS_ROPE);
    const int sub = lane & 7;
    for (int row = gw; row < T; row += NGW) {
        const GAS f32x2v* cs = rope + (size_t)(row & (SEQ - 1)) * 32 + sub * 4;
        rope_piece(Q + (size_t)row * D + lane * 8, qg + sub * 8, cs, attn_body::C2);
        rope_piece(Q + (size_t)row * D + 512 + lane * 8, qg + sub * 8, cs, attn_body::C2);
        if (lane < 32) rope_piece(Kb + (size_t)row * 256 + lane * 8, kg + sub * 8, cs, 1.0f);
    }
}
__device__ __noinline__ void phase_vstats(TC c_, gptr ws_) {
    TC_UNPACK(); gptr ws = uni(ws_); const GAS bf16* Z = (const GAS bf16*)(ws + WS_MIX); GAS f32x2v* stats = (GAS f32x2v*)(ws + WS_STATS);
    for (int row = gw; row < T; row += NGW) {
        const GAS v4u* p = (const GAS v4u*)(Z + (size_t)row * 4096 + 2048);
        float x[32]; float s = 0.f;
#pragma unroll
        for (int j = 0; j < 4; ++j) { const v4u w = p[lane + 64 * j]; x[8 * j] = bflo(w.x); x[8 * j + 1] = bfhi(w.x); x[8 * j + 2] = bflo(w.y); x[8 * j + 3] = bfhi(w.y); x[8 * j + 4] = bflo(w.z); x[8 * j + 5] = bfhi(w.z); x[8 * j + 6] = bflo(w.w); x[8 * j + 7] = bfhi(w.w); }
#pragma unroll
        for (int i = 0; i < 32; ++i) s += x[i];
        const float mean = wave_sum(s) * (1.0f / 2048.0f); float s2 = 0.f;
#pragma unroll
        for (int i = 0; i < 32; ++i) { const float d = x[i] - mean; s2 += d * d; }
        const float rstd = 1.0f / sqrtf(wave_sum(s2) * (1.0f / 2048.0f) + LN_EPS);
        if (lane == 0) stats[row] = (f32x2v){mean, rstd};
    }
}
__device__ __forceinline__ void phase_spatial(TC c_, gptr ws_, const GAS float* ng_, const GAS float* nb_, const GAS float* bs_) {
    TC_UNPACK(); gptr ws = uni(ws_); const GAS float* ng = UNIP(const GAS float*, ng_); const GAS float* nb = UNIP(const GAS float*, nb_); const GAS float* bs = UNIP(const GAS float*, bs_);
    const GAS bf16* Z = (const GAS bf16*)(ws + WS_MIX); const GAS f32x2v* stats = (const GAS f32x2v*)(ws + WS_STATS); const GAS bf16* Wsb = (const GAS bf16*)(ws + WS_WS); GAS unsigned char* GU = (GAS unsigned char*)(ws + WS_MIX + 256 * MiB);
    typedef short bf16x8 __attribute__((ext_vector_type(8)));
    constexpr int PITCH = 136, VP = 132;
    LAS bf16* WsL = (LAS bf16*)(lds + RING_OFF);
    LAS bf16* VtL = WsL + 128 * PITCH;
    LAS unsigned* Vt32 = (LAS unsigned*)VtL;
    const int fr = lane & 15, fq = lane >> 4, pr = wave >> 2, dc = wave & 3;
    const int ql = (tid & 7) + 8 * (tid >> 8), dch = (tid >> 3) & 31, d0 = dch * 8; const bool odd = tid & 1;
    v4u wv[8]; f32x2v st[8];
    int u = blockIdx.x;
    if (u < 2048) { const int c = u >> 3, g = u & 7;
#pragma unroll
        for (int it = 0; it < 8; ++it) { const size_t t = (size_t)c * 128 + 16 * it + ql; wv[it] = *(const GAS v4u*)(Z + t * 4096 + 2048 + g * 256 + d0); st[it] = stats[t]; } }
#pragma unroll 1
    for (; u < 2048; u += G) {
        const int c = u >> 3, g = u & 7;
        const f32x4 g0 = *(const GAS f32x4*)(ng + g * 256 + d0), g1 = *(const GAS f32x4*)(ng + g * 256 + d0 + 4), b0 = *(const GAS f32x4*)(nb + g * 256 + d0), b1 = *(const GAS f32x4*)(nb + g * 256 + d0 + 4);
        const float gg[8] = {g0.x, g0.y, g0.z, g0.w, g1.x, g1.y, g1.z, g1.w}, bb[8] = {b0.x, b0.y, b0.z, b0.w, b1.x, b1.y, b1.z, b1.w};
#pragma unroll
        for (int it = 0; it < 4; ++it) { const int id = it * 512 + tid, p = id >> 4, ch = id & 15; const v4u w = *(const GAS v4u*)(Wsb + (size_t)g * 16384 + p * 128 + ch * 8); *(LAS v4u*)(WsL + p * PITCH + ch * 8) = w; }
#pragma unroll
        for (int it = 0; it < 8; ++it) { float x[8]; unpack8(wv[it], x); unsigned y[8];
#pragma unroll
            for (int i = 0; i < 8; ++i) y[i] = f2bf((x[i] - st[it].x) * st[it].y * gg[i] + bb[i]);
            const int qh = (16 * it + ql) >> 1;
#pragma unroll
            for (int j = 0; j < 4; ++j) { const unsigned mine = odd ? y[4 + j] : y[j], send = odd ? y[j] : y[4 + j];
                const unsigned got = dppu<0xB1>(0u, send);
                const int dd = d0 + (odd ? 4 : 0) + j, rho = (dd & ~63) + 16 * ((dd >> 2) & 3) + 4 * ((dd >> 4) & 3) + (dd & 3);
                Vt32[rho * (VP / 2) + qh] = odd ? (got | (mine << 16)) : (mine | (got << 16)); } }
        __syncthreads();
        v4u uu[4][2];
#pragma unroll
        for (int m = 0; m < 4; ++m) { const size_t t = (size_t)c * 128 + 64 * pr + 16 * m + fr; const GAS v4u* up = (const GAS v4u*)(Z + t * 4096 + g * 256 + 64 * dc + 16 * fq); uu[m][0] = up[0]; uu[m][1] = up[1]; }
        { const int un = u + G; if (un < 2048) { const int cn = un >> 3, gn = un & 7;
#pragma unroll
            for (int it = 0; it < 8; ++it) { const size_t t = (size_t)cn * 128 + 16 * it + ql; wv[it] = *(const GAS v4u*)(Z + t * 4096 + 2048 + gn * 256 + d0); st[it] = stats[t]; } } }
        f32x4 acc[4][4];
#pragma unroll
        for (int m = 0; m < 4; ++m)
#pragma unroll
            for (int n = 0; n < 4; ++n) acc[m][n] = (f32x4){0.f, 0.f, 0.f, 0.f};
#pragma unroll 1
        for (int k = 0; k < 4; ++k) {
            bf16x8 af[4], bfr[4];
#pragma unroll
            for (int m = 0; m < 4; ++m) af[m] = *(const LAS bf16x8*)(WsL + (64 * pr + 16 * m + fr) * PITCH + 32 * k + 8 * fq);
#pragma unroll
            for (int n = 0; n < 4; ++n) { const LAS v2u* p = (const LAS v2u*)(VtL + (64 * dc + 16 * n + fr) * VP + 32 * k + 8 * fq); const v2u lo = p[0], hi = p[1]; bfr[n] = __builtin_bit_cast(bf16x8, (v4u){lo.x, lo.y, hi.x, hi.y}); }
#pragma unroll
            for (int m = 0; m < 4; ++m)
#pragma unroll
                for (int n = 0; n < 4; ++n) acc[m][n] = __builtin_amdgcn_mfma_f32_16x16x32_bf16(bfr[n], af[m], acc[m][n], 0, 0, 0);
        }
#pragma unroll
        for (int m = 0; m < 4; ++m) { const int p = 64 * pr + 16 * m + fr; const float bsp = bs[g * 128 + p]; const size_t t = (size_t)c * 128 + p;
            float uf[16]; { float x8[8]; unpack8(uu[m][0], x8);
#pragma unroll
                for (int i = 0; i < 8; ++i) uf[i] = x8[i];
                unpack8(uu[m][1], x8);
#pragma unroll
                for (int i = 0; i < 8; ++i) uf[8 + i] = x8[i]; }
            v4u w;
#pragma unroll
            for (int n = 0; n < 4; ++n) { const f32x4 r = (acc[m][n] + bsp) * (f32x4){uf[4 * n], uf[4 * n + 1], uf[4 * n + 2], uf[4 * n + 3]}; w[n] = pk4f8(r.x, r.y, r.z, r.w); }
            *(GAS v4u*)(GU + t * 2048 + g * 256 + 64 * dc + 16 * fq) = w; }
        __syncthreads();
    }
}
__device__ __forceinline__ void conv_row(const GAS bf16* Hc, const GAS float* cw, GAS unsigned char* Gc, int row, int lane) {
    const int s = row & (SEQ - 1);
#pragma unroll
    for (int jj = 0; jj < 2; ++jj) { const int ch = (lane + 64 * jj) * 8;
        float acc[8];
#pragma unroll
        for (int i = 0; i < 8; ++i) acc[i] = 0.f;
#pragma unroll
        for (int k = 0; k < 3; ++k) { const int sk = s + k - 1; if (sk < 0 || sk >= SEQ) continue; const size_t r2 = (size_t)(row + k - 1) * 3072;
            float cc[8], xv[8]; unpack8(*(const GAS v4u*)(Hc + r2 + 1024 + ch), cc); unpack8(*(const GAS v4u*)(Hc + r2 + 2048 + ch), xv);
            const f32x4 w0 = *(const GAS f32x4*)(cw + k * 1024 + ch), w1 = *(const GAS f32x4*)(cw + k * 1024 + ch + 4); const float ww[8] = {w0.x, w0.y, w0.z, w0.w, w1.x, w1.y, w1.z, w1.w};
#pragma unroll
            for (int i = 0; i < 8; ++i) acc[i] += cc[i] * xv[i] * ww[i]; }
        float bg[8]; unpack8(*(const GAS v4u*)(Hc + (size_t)row * 3072 + ch), bg);
        v2u o; o.x = pk4f8(bg[0] * acc[0], bg[1] * acc[1], bg[2] * acc[2], bg[3] * acc[3]); o.y = pk4f8(bg[4] * acc[4], bg[5] * acc[5], bg[6] * acc[6], bg[7] * acc[7]);
        *(GAS v2u*)(Gc + (size_t)row * 1024 + ch) = o; }
}
__device__ __noinline__ void phase_conv(TC c_, gptr ws_, const GAS float* cw_) {
    TC_UNPACK(); gptr ws = uni(ws_); const GAS float* cw = UNIP(const GAS float*, cw_);
    const GAS bf16* Hc = (const GAS bf16*)(ws + WS_MIX); GAS unsigned char* Gc = (GAS unsigned char*)(ws + WS_MIX + 192 * MiB);
    for (int row = gw; row < T; row += 2 * NGW) { conv_row(Hc, cw, Gc, row, lane); if (row + NGW < T) conv_row(Hc, cw, Gc, row + NGW, lane); }
}
__device__ __noinline__ void moe_table(TC c_, gptr ws_, int layer_) {
    TC_UNPACK(); gptr ws = uni(ws_); const int layer = uni(layer_);
    GAS unsigned* gcnt = (GAS unsigned*)(ws + WS_CTL) + CW_CNT + layer * 32;
    LAS int* tstart = (LAS int*)(lds + MOE_OFF); LAS int* cntl = tstart + 33;
    if (tid < 32) { int cv = (int)__hip_atomic_load(gcnt + tid, __ATOMIC_RELAXED, __HIP_MEMORY_SCOPE_AGENT); cv = cv < 0 ? 0 : (cv > T ? T : cv); cntl[tid] = cv; }
    __syncthreads();
    if (tid == 0) { int s = 0; for (int e = 0; e < 32; ++e) { tstart[e] = s; s += (cntl[e] + 255) >> 8; } tstart[32] = s; }
    __syncthreads();
}

constexpr int NPH = 1 + 8 * NLAYER;
struct Args { const float* in[24]; float* out; unsigned char* ws; int ph_lo, ph_hi; };
__global__ void __launch_bounds__(512, 2) fwd(Args args) {
    extern __shared__ __attribute__((aligned(16))) unsigned char lds_raw[];
    const int wave_id = __builtin_amdgcn_readfirstlane((int)threadIdx.x >> 6);
    { const int tid0 = threadIdx.x; for (int u = tid0; u < (LDS_BYTES - LDSCTL_OFF) / 4; u += 512) ((LAS unsigned*)((LAS unsigned char*)lds_raw + LDSCTL_OFF))[u] = 0u; }
    __syncthreads();
    const int lo = args.ph_lo, hi = args.ph_hi;
    const bool use_bar = (hi - lo) > 1;
    XcdBarrier bar; bar.bar = (unsigned*)(args.ws + WS_CTL) + CW_BAR; bar.x = 0; bar.st = nullptr; bar.wave = wave_id;
    if (use_bar) bar = xcd_barrier_post((unsigned*)(args.ws + WS_CTL) + CW_BAR, (volatile LAS unsigned*)((LAS unsigned char*)lds_raw + MISC_OFF) + 8);
    bar.wave = wave_id;
#ifndef DUP_MASK
#define DUP_MASK 0
#endif
#define DUPL(b) _Pragma("unroll 1") for (int rep_ = 0; rep_ <= ((DUP_MASK >> (b)) & 1); ++rep_)
#define IN(k) (lo <= (k) && (k) < hi)
#define FUSED_SETUP() const volatile LAS unsigned* fm_ = (const volatile LAS unsigned*)((LAS unsigned char*)lds_raw + MISC_OFF) + 8; \
    const int fnx = __builtin_amdgcn_readfirstlane((int)fm_[0]), frk = __builtin_amdgcn_readfirstlane((int)fm_[2]), fpre = __builtin_amdgcn_readfirstlane((int)fm_[3]); \
    const int fr0 = (int)(((long)TM * fpre) / G_), fnt = (int)(((long)TM * (fpre + fnx)) / G_) - fr0; \
    unsigned* rdy = (unsigned*)(ws + WS_CTL) + CW_RDY + layer * 640
#ifndef DUP_BAR
#define DUP_BAR 0
#endif
#define SEAM(k) do { if (IN((k) + 1)) { _Pragma("unroll 1") for (int rb_ = 0; rb_ <= DUP_BAR; ++rb_) { XcdBarrier b2_ = bar; size_t zb_; asm volatile("s_mov_b64 %0, 0" : "=s"(zb_)); b2_.bar = bar.bar + zb_; xcd_barrier(b2_); } } } while (0)
#define ENTER() size_t zq; asm volatile("s_mov_b64 %0, 0" : "=s"(zq)); unsigned char* ws = args.ws + zq; const gptr wsg = (gptr)ws; (void)wsg; const TC tc = mk_tc(wave_id); const int tid = wave_id * 64 + tc.lane; (void)tid; \
    LAS unsigned char* ring = (LAS unsigned char*)lds_raw + RING_OFF; (void)ring; const int G_ = gridDim.x; (void)G_
#define GIN(k) ((const GAS float*)(args.in[k] + zq))

    if (IN(0)) { ENTER(); DUPL(0) { p0_dense(tc, wsg, GIN(1), GIN(4), GIN(5), GIN(10), GIN(11), GIN(13)); p0_misc(tc, wsg, GIN(0), GIN(8), GIN(21)); } SEAM(0); }

#pragma unroll 1
    for (int layer = 0; layer < NLAYER; ++layer) {
        const int kind = layer % 3, j = layer / 3, pb = 1 + 8 * layer;
        if (kind == 0) {
            if (IN(pb + 0)) {
                ENTER(); bf16* Q = (bf16*)(ws + WS_MIX); bf16* Kb = (bf16*)(ws + WS_MIX + 64 * MiB); bf16* Vb = (bf16*)(ws + WS_MIX + 80 * MiB);
                pg8::DenseSched S{ws + WS_X8, ws + WS_WQKV + (size_t)j * 1536 * 1024, 1024, 1024, T / 256, 6, G_, (int)blockIdx.x};
                pg8::EpiBf16<0, 1> E{Q, 1024, Kb, Vb};
                pg8::gemm_phase<true>(ring, 1024, S, E, tid, WGU_E8M0); if constexpr ((DUP_MASK >> 1) & 1) { pg8::gemm_phase<true>(ring, 1024, S, E, tid, WGU_E8M0); }
                SEAM(pb + 0);
            }
            if (IN(pb + 1)) { ENTER(); phase_qk_rope(tc, wsg, GIN(2) + j * 64, GIN(3) + j * 64); SEAM(pb + 1); }
            if (IN(pb + 2)) {
                ENTER(); bf16* Q = (bf16*)(ws + WS_MIX); bf16* Kb = (bf16*)(ws + WS_MIX + 64 * MiB); bf16* Vb = (bf16*)(ws + WS_MIX + 80 * MiB);
                const attn_body::AttnTensors AT{(const attn_body::bf16*)Q, (const attn_body::bf16*)Kb, (const attn_body::bf16*)Vb, (attn_body::bf16*)(ws + WS_MIX + 128 * MiB)};
                const attn_body::GqaOrder S(G_, (int)blockIdx.x);
                float m0; { float aq = fabsf((GIN(2) + j * 64)[tc.lane]), ak = fabsf((GIN(3) + j * 64)[tc.lane]);
#pragma unroll
                    for (int o = 1; o < 64; o <<= 1) { aq = fmaxf(aq, __shfl_xor(aq, o)); ak = fmaxf(ak, __shfl_xor(ak, o)); }
                    m0 = attn_body::C2 * 64.0f * 1.03f * aq * ak + 0.25f; }
                (void)S;
                unsigned* qctr = (unsigned*)(ws + WS_CTL) + CW_QUE + (layer ? 256 : 0);
                attn_body::attn_phase_dyn<8>((char*)lds_raw + RING_OFF, AT, tid, m0, qctr, (volatile LAS unsigned*)((LAS unsigned char*)lds_raw + MISC_OFF) + 12, (int)(xb_xcc_id() & 7u), layer == 0 ? 192 : 0,
                    [&](int chunk) { p0_chunk(tc, wsg, GIN(20), GIN(22), chunk); });
                SEAM(pb + 2);
            }
            if (IN(pb + 3)) {
                ENTER();
                pg8::DenseSched S{ws + WS_MIX + 128 * MiB, ws + WS_WO + (size_t)j * 1024 * 1024, 1024, 1024, T / 256, 4, G_, (int)blockIdx.x};
                pg8::EpiBf16<0, 0> E{(bf16*)(ws + WS_HB), 1024, nullptr, nullptr};
                pg8::gemm_phase<true>(ring, 1024, S, E, tid, WDN_E8M0, WGU_E8M0); if constexpr ((DUP_MASK >> 4) & 1) { pg8::gemm_phase<true>(ring, 1024, S, E, tid, WDN_E8M0, WGU_E8M0); }
                SEAM(pb + 3);
            }
        } else if (kind == 1) {
            if (IN(pb + 0)) {
                ENTER();
                pg8::DenseSched S{ws + WS_X8, ws + WS_GIN, 1024, 1024, T / 256, 16, G_, (int)blockIdx.x};
                pg8::EpiBf16<1, 0> E{(bf16*)(ws + WS_MIX), 4096, nullptr, nullptr};
                pg8::gemm_phase<true>(ring, 1024, S, E, tid, WGU_E8M0); if constexpr ((DUP_MASK >> 5) & 1) { pg8::gemm_phase<true>(ring, 1024, S, E, tid, WGU_E8M0); }
                SEAM(pb + 0);
            }
            if (IN(pb + 1)) { ENTER(); DUPL(6) phase_vstats(tc, wsg); SEAM(pb + 1); }
            if (IN(pb + 2)) { ENTER(); DUPL(7) phase_spatial(tc, wsg, GIN(6), GIN(7), GIN(9)); SEAM(pb + 2); }
            if (IN(pb + 3)) {
                ENTER();
                pg8::DenseSched S{ws + WS_MIX + 256 * MiB, ws + WS_GOUT, 2048, 2048, T / 256, 4, G_, (int)blockIdx.x};
                pg8::EpiBf16<0, 0> E{(bf16*)(ws + WS_HB), 1024, nullptr, nullptr};
                pg8::gemm_phase<true>(ring, 2048, S, E, tid, WDN_E8M0); if constexpr ((DUP_MASK >> 8) & 1) { pg8::gemm_phase<true>(ring, 2048, S, E, tid, WDN_E8M0); }
                SEAM(pb + 3);
            }
        } else {
            if (IN(pb + 0)) {
                ENTER();
                pg8::DenseSched S{ws + WS_XB, ws + WS_CIN, 2048, 2048, T / 256, 12, G_, (int)blockIdx.x};
                pg8::EpiBf16<0, 0> E{(bf16*)(ws + WS_MIX), 3072, nullptr, nullptr};
                pg8::gemm_phase<false>(ring, 2048, S, E, tid); if constexpr ((DUP_MASK >> 9) & 1) { pg8::gemm_phase<false>(ring, 2048, S, E, tid); }
                SEAM(pb + 0);
            }
            if (IN(pb + 1)) { ENTER(); DUPL(10) phase_conv(tc, wsg, GIN(12)); SEAM(pb + 1); }
            if (IN(pb + 3)) {
                ENTER();
                pg8::DenseSched S{ws + WS_MIX + 192 * MiB, ws + WS_COUT, 1024, 1024, T / 256, 4, G_, (int)blockIdx.x};
                pg8::EpiBf16<0, 0> E{(bf16*)(ws + WS_HB), 1024, nullptr, nullptr};
                pg8::gemm_phase<true>(ring, 1024, S, E, tid, WDN_E8M0); if constexpr ((DUP_MASK >> 11) & 1) { pg8::gemm_phase<true>(ring, 1024, S, E, tid, WDN_E8M0); }
                SEAM(pb + 3);
            }
        }
        if (IN(pb + 4)) {
            ENTER(); if constexpr ((DUP_MASK >> 12) & 1) { phase_ln_router(tc, wsg, GIN(14) + layer * D, GIN(15) + layer * D, GIN(18) + (size_t)layer * D * NE, GIN(19) + layer * NE, layer, 1); __syncthreads(); }
            phase_ln_router(tc, wsg, GIN(14) + layer * D, GIN(15) + layer * D, GIN(18) + (size_t)layer * D * NE, GIN(19) + layer * NE, layer, 0);
            SEAM(pb + 4);
        }
        if (IN(pb + 5) || IN(pb + 6)) { ENTER(); moe_table(tc, wsg, layer); }
        if (IN(pb + 5)) {
            ENTER(); LAS int* tstart = (LAS int*)((LAS unsigned char*)lds_raw + MOE_OFF); LAS int* cntl = tstart + 33; const int TM = __builtin_amdgcn_readfirstlane(tstart[32]);
            FUSED_SETUP();
            pg8::GroupedSched<true> S{ws + WS_X8, ws + WS_WGU + (size_t)layer * 32 * 2048 * 1024, (const int*)(ws + WS_LIST), (const float*)(ws + WS_GLIST), tstart, cntl, 1024, 2048, 8, TM, G_, (int)blockIdx.x,
                                      FUSE_GD, fr0, fnt, frk, fnx, 0, rdy};
            pg8::EpiSwiglu8 E{ws + WS_HM, (const float*)(ws + WS_BGU) + (size_t)layer * 32 * 2048};
            DUPL(13) pg8::gemm_phase<true>(ring, 1024, S, E, tid, WGU_E8M0);
            if (!FUSE_GD) SEAM(pb + 5);
        }
        if (IN(pb + 6)) {
            ENTER(); LAS int* tstart = (LAS int*)((LAS unsigned char*)lds_raw + MOE_OFF); LAS int* cntl = tstart + 33; const int TM = __builtin_amdgcn_readfirstlane(tstart[32]);
            FUSED_SETUP();
            const int fNg = fnt * 8, fi0 = (fNg > frk) ? (fNg - frk + fnx - 1) / fnx : 0;
            pg8::GroupedSched<false> S{ws + WS_HM, ws + WS_WDN + (size_t)layer * 32 * 1024 * 1024, (const int*)(ws + WS_LIST), (const float*)(ws + WS_GLIST), tstart, cntl, 1024, 1024, 4, TM, G_, (int)blockIdx.x,
                                       FUSE_GD, fr0, fnt, frk, fnx, fi0 * fnx - fNg, rdy};
            pg8::EpiDown E{ws + WS_Y, args.in[23] + zq + (size_t)layer * 32 * 1024, ring};
            DUPL(14) pg8::gemm_phase<true>(ring, 1024, S, E, tid, WDN_E8M0);
            SEAM(pb + 6);
        }
        if (IN(pb + 7)) {
            ENTER(); const bool fin = (layer == NLAYER - 1);
            _Pragma("unroll 1") for (int rep_ = 0; rep_ <= ((fin && ((DUP_MASK >> 15) & 1)) ? 1 : 0); ++rep_)
            phase_combine(tc, wsg, GIN(16) + layer * D, GIN(17) + layer * D, fin ? (GAS float*)(args.out + zq) : (GAS float*)nullptr, ((layer + 1) % 3 != 2) ? 1 : 0);
            SEAM(pb + 7);
        }
    }
#undef IN
#undef SEAM
#undef ENTER
}

#ifndef MK_PER_PHASE
#define MK_PER_PHASE 0
#endif
extern "C" void kernel_launch(void* const* d_in, const int* in_sizes, int n_in, void* d_out, int out_size, void* d_ws, size_t ws_size, hipStream_t stream) {
    static int grid = 0;
    if (grid == 0) {
        if (n_in != 24 || in_sizes[0] != T * D || out_size != T * D || ws_size < WS_END) { fprintf(stderr, "kernel_launch: unexpected shapes (n_in %d, in0 %d, out %d, ws %zu); nothing launched\n", n_in, n_in > 0 ? in_sizes[0] : -1, out_size, ws_size); grid = -1; return; }
        int dev = 0, cus = 0, per_cu = 0;
        if (hipGetDevice(&dev) != hipSuccess || hipDeviceGetAttribute(&cus, hipDeviceAttributeMultiprocessorCount, dev) != hipSuccess) { grid = -1; return; }
        if (hipFuncSetAttribute((const void*)fwd, hipFuncAttributeMaxDynamicSharedMemorySize, LDS_BYTES) != hipSuccess) { fprintf(stderr, "kernel_launch: hipFuncSetAttribute failed\n"); grid = -1; return; }
        if (hipOccupancyMaxActiveBlocksPerMultiprocessor(&per_cu, (const void*)fwd, 512, LDS_BYTES) != hipSuccess || per_cu < 1) { fprintf(stderr, "kernel_launch: occupancy query says %d\n", per_cu); }
        (void)hipGetLastError();
        grid = cus;
    }
    if (grid < 0) return;
    if (hipMemsetAsync((char*)d_ws + WS_CTL, 0, CTL_ZERO_BYTES, stream) != hipSuccess) return;
    Args a{};
    for (int i = 0; i < 24; ++i) a.in[i] = (const float*)d_in[i];
    a.out = (float*)d_out; a.ws = (unsigned char*)d_ws;
#if MK_PER_PHASE
    for (int p = 0; p < NPH; ++p) { a.ph_lo = p; a.ph_hi = p + 1; hipLaunchKernelGGL(fwd, dim3(grid), dim3(512), LDS_BYTES, stream, a); }
#else
    a.ph_lo = 0; a.ph_hi = NPH;
    hipLaunchKernelGGL(fwd, dim3(grid), dim3(512), LDS_BYTES, stream, a);
#endif
    const hipError_t le = hipPeekAtLastError();
    if (le != hipSuccess) fprintf(stderr, "kernel_launch: launch failed: %s\n", hipGetErrorName(le));
}
```
